# Optimizing an MI355X kernel written in HIP

```python
import jax, jax.numpy as jnp
from jax import lax
import numpy as np

D_MODEL = 1024
BATCH = 8
SEQ = 8192
DEPTH = 1

D_MIX = D_MODEL
D_LRU = D_MIX // 2
LRU_HEADS = 8
LRU_HEAD_DIM = D_LRU // LRU_HEADS
CONV_WIDTH = 4
LRU_C = 8.0
D_GLA = D_MIX - D_LRU
GLA_HEADS = 4
GLA_DV = D_GLA // GLA_HEADS
GLA_DK = GLA_DV // 2
GLA_GATE_RANK = 16
GLA_GATE_NORM = 16.0
GLA_CHUNK = 64
N_GROUPS = 4
EXPERTS_PER_GROUP = 8
N_EXPERTS = N_GROUPS * EXPERTS_PER_GROUP
TOP_K = 2
D_EXPERT = D_MODEL // 2
MOE_BLOCK = 256
D_IN_PROJ = 2 * D_LRU + 2 * GLA_HEADS * GLA_DK + 2 * D_GLA + GLA_GATE_RANK
EPS = 1e-6

kernel_name = "hybrid_rglru_gla_hmoe_adaln"


def rms_norm(x, gain):
    x32 = x.astype(jnp.float32)
    y = x32 * lax.rsqrt(jnp.mean(x32 * x32, axis=-1, keepdims=True) + EPS)
    return (y * gain.astype(jnp.float32)).astype(x.dtype)


def causal_depthwise_conv(x, w, b):
    seq = x.shape[1]
    xp = jnp.pad(x, ((0, 0), (CONV_WIDTH - 1, 0), (0, 0)))
    return b + sum(w[k] * xp[:, k:k + seq] for k in range(CONV_WIDTH))


def rg_lru(x, w_r, b_r, w_i, b_i, lam):
    bsz, seq, width = x.shape
    xh = x.reshape(bsz, seq, LRU_HEADS, LRU_HEAD_DIM)
    r = jax.nn.sigmoid(jnp.einsum("bshi,hij->bshj", xh, w_r).reshape(bsz, seq, width) + b_r)
    gate_i = jax.nn.sigmoid(jnp.einsum("bshi,hij->bshj", xh, w_i).reshape(bsz, seq, width) + b_i)
    log_a = -LRU_C * r.astype(jnp.float32) * jax.nn.softplus(-lam.astype(jnp.float32))
    a = jnp.exp(log_a)
    u = jnp.sqrt(-jnp.expm1(2.0 * log_a)) * (gate_i * x).astype(jnp.float32)

    def step(h, au):
        a_t, u_t = au
        h = a_t * h + u_t
        return h, h

    _, hs = lax.scan(step, jnp.zeros((bsz, width), jnp.float32),
                     (a.swapaxes(0, 1), u.swapaxes(0, 1)))
    return hs.swapaxes(0, 1).astype(x.dtype)


def gla_chunked(q, k, v, log_alpha):
    bsz, seq, nh, dk = q.shape
    dv = v.shape[-1]
    n = seq // GLA_CHUNK
    f32 = jnp.float32
    q = q.astype(f32).reshape(bsz, n, GLA_CHUNK, nh, dk) * dk ** -0.5
    k = k.astype(f32).reshape(bsz, n, GLA_CHUNK, nh, dk)
    v32 = v.astype(f32).reshape(bsz, n, GLA_CHUNK, nh, dv)
    b = jnp.cumsum(log_alpha.astype(f32).reshape(bsz, n, GLA_CHUNK, nh, dk), axis=2)
    b_last = b[:, :, -1]
    q_dec = q * jnp.exp(b)
    scores = jnp.einsum("bnchd,bnshd->bnhcs", q_dec, k * jnp.exp(-b))
    causal = jnp.tril(jnp.ones((GLA_CHUNK, GLA_CHUNK), dtype=bool))
    scores = jnp.where(causal, scores, 0.0)
    o_intra = jnp.einsum("bnhcs,bnshe->bnche", scores, v32)
    chunk_kv = jnp.einsum("bnchd,bnche->bnhde", k * jnp.exp(b_last[:, :, None] - b), v32)

    def step(state, inp):
        decay, kv = inp
        return decay[..., None] * state + kv, state

    _, states = lax.scan(step, jnp.zeros((bsz, nh, dk, dv), f32),
                         (jnp.exp(b_last).swapaxes(0, 1), chunk_kv.swapaxes(0, 1)))
    o_inter = jnp.einsum("bnchd,bnhde->bnche", q_dec, states.swapaxes(0, 1))
    return (o_intra + o_inter).reshape(bsz, seq, nh, dv).astype(v.dtype)


def hierarchical_moe(h, w_coarse, b_coarse, w_fine, b_fine, w_gate, w_up, w_down):
    bsz, seq, d = h.shape
    f32 = jnp.float32
    n_tok = bsz * seq
    xf = h.reshape(n_tok, d)
    coarse_logits = (xf @ w_coarse).astype(f32) + b_coarse.astype(f32)
    coarse_p = jax.nn.softmax(coarse_logits, axis=-1)
    grp = jnp.argmax(coarse_logits, axis=-1).astype(jnp.int32)
    p_grp = jnp.take_along_axis(coarse_p, grp[:, None], axis=-1)
    fine_logits = ((xf @ w_fine).astype(f32) + b_fine.astype(f32)).reshape(
        n_tok, N_GROUPS, EXPERTS_PER_GROUP)
    fine_logits = jnp.take_along_axis(fine_logits, grp[:, None, None], axis=1)[:, 0]
    top_p, top_i = lax.top_k(jax.nn.softmax(fine_logits, axis=-1), TOP_K)
    weights = p_grp * top_p / jnp.sum(top_p, axis=-1, keepdims=True)
    experts = grp[:, None] * EXPERTS_PER_GROUP + top_i.astype(jnp.int32)

    n_assign = n_tok * TOP_K
    flat_e = experts.reshape(n_assign)
    flat_t = jnp.repeat(jnp.arange(n_tok, dtype=jnp.int32), TOP_K)
    flat_w = weights.reshape(n_assign)
    order = jnp.argsort(flat_e)
    se, st, sw = flat_e[order], flat_t[order], flat_w[order]
    counts = jnp.bincount(flat_e, length=N_EXPERTS)
    starts = jnp.cumsum(counts) - counts
    padded = (counts + MOE_BLOCK - 1) // MOE_BLOCK * MOE_BLOCK
    pends = jnp.cumsum(padded)
    dest = (pends - padded)[se] + jnp.arange(n_assign, dtype=jnp.int32) - starts[se]
    cap = (n_assign + MOE_BLOCK - 1) // MOE_BLOCK * MOE_BLOCK + N_EXPERTS * MOE_BLOCK
    n_blocks = cap // MOE_BLOCK
    buf_t = jnp.zeros((cap,), jnp.int32).at[dest].set(st)
    buf_w = jnp.zeros((cap,), f32).at[dest].set(sw)
    block_e = jnp.minimum(
        jnp.searchsorted(pends, jnp.arange(n_blocks, dtype=jnp.int32) * MOE_BLOCK, side="right"),
        N_EXPERTS - 1)

    def run_block(args):
        tok, e = args
        xb = xf[tok]
        hid = jax.nn.silu(xb @ w_gate[e]) * (xb @ w_up[e])
        return hid @ w_down[e]

    outs = lax.map(run_block, (buf_t.reshape(n_blocks, MOE_BLOCK), block_e))
    y = jnp.zeros((n_tok, d), f32).at[buf_t].add(
        outs.reshape(cap, d).astype(f32) * buf_w[:, None])
    return y.reshape(bsz, seq, d).astype(h.dtype)


def setup_inputs(seed: int = 0) -> dict:
    key = jax.random.key(seed)
    ks = jax.random.split(key, 32)
    f32 = jnp.float32
    L = DEPTH
    qk = GLA_HEADS * GLA_DK

    def nrm(k, shape, scale):
        return jax.random.normal(k, shape, f32) * scale

    a_c = jax.random.uniform(ks[14], (L, D_LRU), f32, 0.9, 0.999)
    a_base = a_c ** (1.0 / LRU_C)
    lru_lambda = jnp.log(a_base) - jnp.log1p(-a_base)
    return {
        "x": nrm(ks[0], (BATCH, SEQ, D_MODEL), 1.0),
        "c": nrm(ks[1], (BATCH, D_MODEL), 1.0),
        "w_ada": nrm(ks[2], (L, D_MODEL, 6 * D_MODEL), D_MODEL ** -0.5),
        "b_ada": nrm(ks[3], (L, 6 * D_MODEL), 0.02),
        "g_mix": 1.0 + nrm(ks[4], (L, D_MODEL), 0.1),
        "g_ffn": 1.0 + nrm(ks[5], (L, D_MODEL), 0.1),
        "g_final": 1.0 + nrm(ks[6], (D_MODEL,), 0.1),
        "w_in": nrm(ks[7], (L, D_MODEL, D_IN_PROJ), D_MODEL ** -0.5),
        "conv_w": nrm(ks[8], (L, CONV_WIDTH, D_LRU), CONV_WIDTH ** -0.5),
        "conv_b": nrm(ks[9], (L, D_LRU), 0.02),
        "lru_wr": nrm(ks[10], (L, LRU_HEADS, LRU_HEAD_DIM, LRU_HEAD_DIM), LRU_HEAD_DIM ** -0.5),
        "lru_br": nrm(ks[11], (L, D_LRU), 0.02),
        "lru_wi": nrm(ks[12], (L, LRU_HEADS, LRU_HEAD_DIM, LRU_HEAD_DIM), LRU_HEAD_DIM ** -0.5),
        "lru_bi": nrm(ks[13], (L, D_LRU), 0.02),
        "lru_lambda": lru_lambda,
        "gla_wa2": nrm(ks[15], (L, GLA_GATE_RANK, qk), GLA_GATE_RANK ** -0.5),
        "gla_ba": nrm(ks[16], (L, qk), 0.02),
        "gla_gnorm": 1.0 + nrm(ks[17], (L, GLA_DV), 0.1),
        "w_out": nrm(ks[18], (L, D_MIX, D_MODEL), D_MIX ** -0.5),
        "w_coarse": nrm(ks[19], (L, D_MODEL, N_GROUPS), D_MODEL ** -0.5),
        "b_coarse": nrm(ks[20], (L, N_GROUPS), 0.01),
        "w_fine": nrm(ks[21], (L, D_MODEL, N_EXPERTS), D_MODEL ** -0.5),
        "b_fine": nrm(ks[22], (L, N_EXPERTS), 0.01),
        "w_gate": nrm(ks[23], (L, N_EXPERTS, D_MODEL, D_EXPERT), D_MODEL ** -0.5),
        "w_up": nrm(ks[24], (L, N_EXPERTS, D_MODEL, D_EXPERT), D_MODEL ** -0.5),
        "w_down": nrm(ks[25], (L, N_EXPERTS, D_EXPERT, D_MODEL), D_EXPERT ** -0.5),
    }


def reference(x, c, w_ada, b_ada, g_mix, g_ffn, g_final, w_in, conv_w, conv_b, lru_wr, lru_br,
              lru_wi, lru_bi, lru_lambda, gla_wa2, gla_ba, gla_gnorm, w_out, w_coarse, b_coarse,
              w_fine, b_fine, w_gate, w_up, w_down):
    bsz, seq, _ = x.shape
    qk = GLA_HEADS * GLA_DK
    splits = [D_LRU, 2 * D_LRU, 2 * D_LRU + qk, 2 * D_LRU + 2 * qk,
              2 * D_LRU + 2 * qk + D_GLA, 2 * D_LRU + 2 * qk + 2 * D_GLA]
    for l in range(DEPTH):
        mod = jax.nn.silu(c) @ w_ada[l] + b_ada[l]
        sh1, sc1, gt1, sh2, sc2, gt2 = [m[:, None, :] for m in jnp.split(mod, 6, axis=-1)]

        h = rms_norm(x, g_mix[l]) * (1 + sc1) + sh1
        proj = h @ w_in[l]
        lru_x, lru_y, q, k, v, g_out, gate_lr = jnp.split(proj, splits, axis=-1)

        lru_h = rg_lru(causal_depthwise_conv(lru_x, conv_w[l], conv_b[l]),
                       lru_wr[l], lru_br[l], lru_wi[l], lru_bi[l], lru_lambda[l])
        lru_out = lru_h * jax.nn.gelu(lru_y)

        log_alpha = jax.nn.log_sigmoid(
            (gate_lr @ gla_wa2[l] + gla_ba[l]).astype(jnp.float32)) / GLA_GATE_NORM
        o = gla_chunked(q.reshape(bsz, seq, GLA_HEADS, GLA_DK),
                        k.reshape(bsz, seq, GLA_HEADS, GLA_DK),
                        v.reshape(bsz, seq, GLA_HEADS, GLA_DV),
                        log_alpha.reshape(bsz, seq, GLA_HEADS, GLA_DK))
        gla_out = rms_norm(o, gla_gnorm[l]).reshape(bsz, seq, D_GLA) * jax.nn.silu(g_out)

        mix = jnp.concatenate([lru_out, gla_out], axis=-1) @ w_out[l]
        x = x + gt1 * mix

        h2 = rms_norm(x, g_ffn[l]) * (1 + sc2) + sh2
        x = x + gt2 * hierarchical_moe(h2, w_coarse[l], b_coarse[l], w_fine[l], b_fine[l],
                                       w_gate[l], w_up[l], w_down[l])
    return rms_norm(x, g_final)
```

```cpp
#include <hip/hip_runtime.h>
#include <cstdio>
#include <cstdint>

#define GAS __attribute__((address_space(1)))
#define LAS __attribute__((address_space(3)))
typedef unsigned short bf16_t;
typedef short bf16x8 __attribute__((ext_vector_type(8)));
typedef float f32x4 __attribute__((ext_vector_type(4)));
typedef float f32x2 __attribute__((ext_vector_type(2)));
typedef unsigned u32x4 __attribute__((ext_vector_type(4)));
typedef unsigned u32x2 __attribute__((ext_vector_type(2)));

constexpr int NB = 8, SEQ = 8192, T = NB * SEQ, D = 1024;
constexpr int DL = 512, LH = 8, LHD = 64;
constexpr int GH = 4, GDK = 64, GDV = 128;
constexpr int NE = 32, DE = 512;
constexpr int NIN = 2576;
constexpr int NPROJ = 2816;
constexpr int C_LX = 0, C_LY = 512, C_Q = 1024, C_K = 1280, C_V = 1536, C_G = 2048, C_LA = 2560;
constexpr int NMOD = 6 * D;
constexpr int MAXSLOT = 2 * T + NE * 256;
constexpr float EPS = 1e-6f;

constexpr size_t MiB = 1u << 20;
constexpr size_t WS_CTL = 0, CTL_BYTES = 1 * MiB;
constexpr size_t WS_MODP = 1 * MiB;
constexpr size_t WS_MOD = 4 * MiB;
constexpr size_t WS_WIN = 5 * MiB;
constexpr size_t WS_WOUT = 11 * MiB;
constexpr size_t WS_WGU = 13 * MiB;
constexpr size_t WS_WD = 77 * MiB;
constexpr size_t WS_WRT = 109 * MiB;
constexpr size_t WS_LSUM = 110 * MiB;
constexpr size_t WS_TOKE = 111 * MiB;
constexpr size_t WS_TOKW = 112 * MiB;
constexpr size_t WS_TOKS = 113 * MiB;
constexpr size_t WS_BCNT = 114 * MiB;
constexpr size_t WS_SLOTT = 115 * MiB;
constexpr size_t WS_SLOTW = 116 * MiB;
constexpr size_t WS_H = 128 * MiB;
constexpr size_t WS_PROJ = 256 * MiB;
constexpr size_t WS_X1 = 608 * MiB;
constexpr size_t WS_KVT = 736 * MiB;
constexpr size_t WS_ST = 872 * MiB;
constexpr size_t WS_DEC = 936 * MiB;
constexpr size_t WS_NA = 736 * MiB;
constexpr size_t WS_NU = 864 * MiB;
constexpr size_t WS_END = 992 * MiB;

constexpr int LDS_BYTES = 147456;

__device__ __forceinline__ unsigned f2bf(float f) { unsigned u = __builtin_bit_cast(unsigned, f); return (u + 0x7fffu + ((u >> 16) & 1u)) >> 16; }
__device__ __forceinline__ unsigned pk2(float lo, float hi) { return f2bf(lo) | (f2bf(hi) << 16); }
__device__ __forceinline__ float bf2f(unsigned short b) { return __builtin_bit_cast(float, ((unsigned)b) << 16); }
__device__ __forceinline__ float bflo(unsigned w) { return __builtin_bit_cast(float, w << 16); }
__device__ __forceinline__ float bfhi(unsigned w) { return __builtin_bit_cast(float, w & 0xffff0000u); }
__device__ __forceinline__ float wave_sum(float v) {
#pragma unroll
    for (int o = 1; o < 64; o <<= 1) v += __shfl_xor(v, o);
    return v;
}
__device__ __forceinline__ float sigmoidf_(float x) { return 1.0f / (1.0f + __expf(-x)); }
__device__ __forceinline__ float siluf_(float x) { return x / (1.0f + __expf(-x)); }
__device__ __forceinline__ float gelu_tanh(float x) { const float u = 1.5957691216057308f * (x + 0.044715f * x * x * x); return x / (1.0f + __expf(-u)); }
__host__ __device__ __forceinline__ int perm32(int rho) { const int n = rho >> 4, i = rho & 15; return 8 * (i >> 2) + 4 * n + (i & 3); }

struct Args { const float* in[26]; float* out; unsigned char* ws; int ph_lo, ph_hi; };

struct Frame {
    LAS unsigned char* lds;
    int tid, lane, wave;
    const float* const* in;
    unsigned char* ws;
    float* out;
};

struct Unit { int pm, pn, e, row0; };

template <class Sched, class Epi>
__device__ __forceinline__ void gemm_simple(const Sched& S, const Epi& E) {
    const int tid = threadIdx.x, wid = tid >> 6, lane = tid & 63, wr = wid >> 2, wc = wid & 3, fr = lane & 15, fq = lane >> 4;
    const int K = S.K;
    for (int i = 0;; ++i) {
        Unit u; if (!S.next(i, u)) break;
        f32x4 acc[2][2][4][2];
#pragma unroll
        for (int a = 0; a < 2; ++a)
#pragma unroll
            for (int b = 0; b < 2; ++b)
#pragma unroll
                for (int m = 0; m < 4; ++m)
#pragma unroll
                    for (int n = 0; n < 2; ++n) acc[a][b][m][n] = (f32x4){0.f, 0.f, 0.f, 0.f};
        const bf16_t* arow[2][4]; const bf16_t* brow[2][2];
#pragma unroll
        for (int ai = 0; ai < 2; ++ai)
#pragma unroll
            for (int m = 0; m < 4; ++m) arow[ai][m] = S.a_row(u, ai * 128 + wr * 64 + m * 16 + fr) + 8 * fq;
#pragma unroll
        for (int bj = 0; bj < 2; ++bj)
#pragma unroll
            for (int n = 0; n < 2; ++n) { const int rho = 16 * n + fr; brow[bj][n] = S.b_row(u, bj * 128 + wc * 32 + (Epi::PERM ? perm32(rho) : rho)) + 8 * fq; }
        for (int k0 = 0; k0 < K; k0 += 32) {
            bf16x8 af[2][4], bfr[2][2];
#pragma unroll
            for (int ai = 0; ai < 2; ++ai)
#pragma unroll
                for (int m = 0; m < 4; ++m) af[ai][m] = *(const bf16x8*)(arow[ai][m] + k0);
#pragma unroll
            for (int bj = 0; bj < 2; ++bj)
#pragma unroll
                for (int n = 0; n < 2; ++n) bfr[bj][n] = *(const bf16x8*)(brow[bj][n] + k0);
#pragma unroll
            for (int ai = 0; ai < 2; ++ai)
#pragma unroll
                for (int bj = 0; bj < 2; ++bj)
#pragma unroll
                    for (int m = 0; m < 4; ++m)
#pragma unroll
                        for (int n = 0; n < 2; ++n) acc[ai][bj][m][n] = __builtin_amdgcn_mfma_f32_16x16x32_bf16(bfr[bj][n], af[ai][m], acc[ai][bj][m][n], 0, 0, 0);
        }
        E(acc, u, wr, wc, fr, fq);
    }
}

struct DenseSched {
    const bf16_t* A; const bf16_t* Bt; int K, nM, nN, G, c;
    __device__ __forceinline__ bool next(int i, Unit& u) const { const int L = i * G + c; if (L >= nM * nN) return false; u.pm = L / nN; u.pn = L % nN; u.e = 0; u.row0 = u.pm * 256; return true; }
    __device__ __forceinline__ const bf16_t* a_row(const Unit& u, int r) const { return A + (size_t)(u.pm * 256 + r) * K; }
    __device__ __forceinline__ const bf16_t* b_row(const Unit& u, int c_) const { return Bt + (size_t)(u.pn * 256 + c_) * K; }
};
struct MoeSched {
    const bf16_t* A; const bf16_t* Bt; const int* slot_tok; int K; bool gather; size_t estride;
    LAS int* tileE; LAS int* tileRow; int ntiles, G, c;
    __device__ __forceinline__ bool next(int i, Unit& u) const { const int L = i * G + c; if (L >= ntiles * 4) return false; u.pm = L >> 2; u.pn = L & 3; u.e = tileE[u.pm]; u.row0 = tileRow[u.pm]; return true; }
    __device__ __forceinline__ const bf16_t* a_row(const Unit& u, int r) const { const int s = u.row0 + r; return gather ? A + (size_t)slot_tok[s] * K : A + (size_t)s * K; }
    __device__ __forceinline__ const bf16_t* b_row(const Unit& u, int c_) const { return Bt + (size_t)u.e * estride + (size_t)(u.pn * 256 + c_) * K; }
};

__device__ __forceinline__ u32x4 pack8(f32x4 v0, f32x4 v1) { u32x4 w; w.x = pk2(v0[0], v0[1]); w.y = pk2(v0[2], v0[3]); w.z = pk2(v1[0], v1[1]); w.w = pk2(v1[2], v1[3]); return w; }

struct EpiProj {
    static constexpr bool PERM = true;
    bf16_t* P; const float* ba;
    __device__ __forceinline__ void operator()(const f32x4 (&acc)[2][2][4][2], const Unit& u, int wr, int wc, int fr, int fq) const {
        const int row0 = u.pm * 256 + wr * 64 + fr, col0 = u.pn * 256 + wc * 32 + 8 * fq;
#pragma unroll
        for (int ai = 0; ai < 2; ++ai)
#pragma unroll
            for (int m = 0; m < 4; ++m) { bf16_t* rowp = P + (size_t)(row0 + ai * 128 + m * 16) * NPROJ + col0;
#pragma unroll
                for (int bj = 0; bj < 2; ++bj) { f32x4 v0 = acc[ai][bj][m][0], v1 = acc[ai][bj][m][1];
                    if (u.pn == 10) { const float* bp = ba + (col0 + bj * 128 - C_LA);
#pragma unroll
                        for (int j = 0; j < 4; ++j) { float z = v0[j] + bp[j]; v0[j] = (fminf(z, 0.f) - log1pf(__expf(-fabsf(z)))) * 0.0625f; z = v1[j] + bp[4 + j]; v1[j] = (fminf(z, 0.f) - log1pf(__expf(-fabsf(z)))) * 0.0625f; } }
                    *(u32x4*)(rowp + bj * 128) = pack8(v0, v1); } }
    }
};
struct EpiX1 {
    static constexpr bool PERM = true;
    bf16_t* X1; const float* x; const float* mod;
    __device__ __forceinline__ void operator()(const f32x4 (&acc)[2][2][4][2], const Unit& u, int wr, int wc, int fr, int fq) const {
        const int row0 = u.pm * 256 + wr * 64 + fr, col0 = u.pn * 256 + wc * 32 + 8 * fq;
        const float* gt = mod + (size_t)(u.pm / 32) * NMOD + 2 * D;
#pragma unroll
        for (int bj = 0; bj < 2; ++bj) { const int c = col0 + bj * 128; const f32x4 g0 = *(const f32x4*)(gt + c), g1 = *(const f32x4*)(gt + c + 4);
#pragma unroll
            for (int ai = 0; ai < 2; ++ai)
#pragma unroll
                for (int m = 0; m < 4; ++m) { const size_t o = (size_t)(row0 + ai * 128 + m * 16) * D + c;
                    const f32x4 x0 = *(const f32x4*)(x + o), x1 = *(const f32x4*)(x + o + 4);
                    *(u32x4*)(X1 + o) = pack8(x0 + g0 * acc[ai][bj][m][0], x1 + g1 * acc[ai][bj][m][1]); } }
    }
};
struct EpiSwiglu {
    static constexpr bool PERM = true;
    bf16_t* HID;
    __device__ __forceinline__ void operator()(const f32x4 (&acc)[2][2][4][2], const Unit& u, int wr, int wc, int fr, int fq) const {
        const int row0 = u.row0 + wr * 64 + fr, col0 = u.pn * 128 + wc * 32 + 8 * fq;
#pragma unroll
        for (int ai = 0; ai < 2; ++ai)
#pragma unroll
            for (int m = 0; m < 4; ++m) { f32x4 h0, h1;
#pragma unroll
                for (int j = 0; j < 4; ++j) { h0[j] = siluf_(acc[ai][0][m][0][j]) * acc[ai][1][m][0][j]; h1[j] = siluf_(acc[ai][0][m][1][j]) * acc[ai][1][m][1][j]; }
                *(u32x4*)(HID + (size_t)(row0 + ai * 128 + m * 16) * DE + col0) = pack8(h0, h1); }
    }
};
struct EpiDown {
    static constexpr bool PERM = true;
    bf16_t* O; const float* slot_w;
    __device__ __forceinline__ void operator()(const f32x4 (&acc)[2][2][4][2], const Unit& u, int wr, int wc, int fr, int fq) const {
        const int row0 = u.row0 + wr * 64 + fr, col0 = u.pn * 256 + wc * 32 + 8 * fq;
#pragma unroll
        for (int ai = 0; ai < 2; ++ai)
#pragma unroll
            for (int m = 0; m < 4; ++m) { const int r = row0 + ai * 128 + m * 16; const float w = slot_w[r];
#pragma unroll
                for (int bj = 0; bj < 2; ++bj) *(u32x4*)(O + (size_t)r * D + col0 + bj * 128) = pack8(acc[ai][bj][m][0] * w, acc[ai][bj][m][1] * w); }
    }
};

__device__ __forceinline__ float mod_at(const Frame& F, int b, int j) {
    const float* modp = (const float*)(F.ws + WS_MODP);
    float s = F.in[3][j];
#pragma unroll
    for (int kc = 0; kc < 16; ++kc) s += modp[(size_t)(kc * 8 + b) * NMOD + j];
    return s;
}

__device__ __forceinline__ void transpose_item(const float* W, int ldw, int k0, int n0, bf16_t* WT, int ldk, int drow0, LAS float* scr, int lane) {
#pragma unroll 8
    for (int i = 0; i < 32; ++i) { const int kk = 2 * i + (lane >> 5); scr[kk * 33 + (lane & 31)] = W[(size_t)(k0 + kk) * ldw + n0 + (lane & 31)]; }
    asm volatile("s_waitcnt lgkmcnt(0)" ::: "memory");
    const int c = lane & 7;
#pragma unroll
    for (int j = 0; j < 4; ++j) { const int n = (lane >> 3) + 8 * j; const LAS float* s = scr + (8 * c) * 33 + n;
        u32x4 o; o.x = pk2(s[0 * 33], s[1 * 33]); o.y = pk2(s[2 * 33], s[3 * 33]); o.z = pk2(s[4 * 33], s[5 * 33]); o.w = pk2(s[6 * 33], s[7 * 33]);
        *(u32x4*)(WT + (size_t)(drow0 + n) * ldk + k0 + 8 * c) = o; }
    asm volatile("s_waitcnt lgkmcnt(0)" ::: "memory");
}

__device__ __forceinline__ void phase_p0a(Frame& F) {
    const float* c = F.in[1]; const float* w_ada = F.in[2];
    LAS float* sc = (LAS float*)F.lds;
    for (int i = F.tid; i < NB * D; i += 512) sc[i] = siluf_(c[i]);
    __syncthreads();
    const int gw = blockIdx.x * 8 + F.wave, NGW = gridDim.x * 8;
    float* modp = (float*)(F.ws + WS_MODP);
    for (int it = gw; it < 96 * 16; it += NGW) {
        const int jc = it % 96, kc = it / 96, j = jc * 64 + F.lane;
        float a[8] = {0.f, 0.f, 0.f, 0.f, 0.f, 0.f, 0.f, 0.f};
#pragma unroll 8
        for (int kk = 0; kk < 64; ++kk) { const int k = kc * 64 + kk; const float w = w_ada[(size_t)k * NMOD + j];
#pragma unroll
            for (int b = 0; b < 8; ++b) a[b] += sc[b * D + k] * w; }
#pragma unroll
        for (int b = 0; b < 8; ++b) modp[(size_t)(kc * 8 + b) * NMOD + j] = a[b];
    }
    LAS float* scr = (LAS float*)(F.lds + 32768 + F.wave * 8704);
    bf16_t* win_t = (bf16_t*)(F.ws + WS_WIN); bf16_t* wout_t = (bf16_t*)(F.ws + WS_WOUT); bf16_t* wgu_t = (bf16_t*)(F.ws + WS_WGU); bf16_t* wd_t = (bf16_t*)(F.ws + WS_WD);
    constexpr int I_IN = 16 * 80, I_OUT = 16 * 32, I_G = NE * 16 * 16, I_D = NE * 8 * 32, I_A = 16 * 8;
    constexpr int NIT = I_IN + I_OUT + 2 * I_G + I_D + I_A;
    for (int it = gw; it < NIT; it += NGW) {
        int r = it;
        if (r < I_IN) { const int kb = r / 80, nb = r % 80; transpose_item(F.in[7], NIN, 64 * kb, 32 * nb, win_t, D, 32 * nb, scr, F.lane); continue; } r -= I_IN;
        if (r < I_OUT) { const int kb = r / 32, nb = r % 32; transpose_item(F.in[18], D, 64 * kb, 32 * nb, wout_t, D, 32 * nb, scr, F.lane); continue; } r -= I_OUT;
        if (r < 2 * I_G) { const int up = r >= I_G; if (up) r -= I_G; const int e = r / 256, q = r % 256, kb = q / 16, nb = q % 16, n0 = 32 * nb;
            transpose_item(F.in[up ? 24 : 23] + (size_t)e * D * DE, DE, 64 * kb, n0, wgu_t + (size_t)e * D * D, D, (n0 / 128) * 256 + (n0 % 128) + (up ? 128 : 0), scr, F.lane); continue; } r -= 2 * I_G;
        if (r < I_D) { const int e = r / 256, q = r % 256, kb = q / 32, nb = q % 32; transpose_item(F.in[25] + (size_t)e * DE * D, D, 64 * kb, 32 * nb, wd_t + (size_t)e * D * DE, DE, 32 * nb, scr, F.lane); continue; } r -= I_D;
        {
            const int kb = r / 8, nb = r % 8, k = 64 * kb + F.lane; const float* wa2 = F.in[15];
            float g[16];
#pragma unroll
            for (int q = 0; q < 16; ++q) g[q] = F.in[7][(size_t)k * NIN + 2560 + q];
            for (int n = 0; n < 32; ++n) { float s = 0.f;
#pragma unroll
                for (int q = 0; q < 16; ++q) s += g[q] * wa2[q * 256 + nb * 32 + n];
                win_t[(size_t)(C_LA + nb * 32 + n) * D + k] = (bf16_t)f2bf(s); }
        }
    }
    float* wrt = (float*)(F.ws + WS_WRT);
    for (int i = blockIdx.x * 512 + F.tid; i < 36 * D; i += gridDim.x * 512) { const int n = i / D, k = i % D; wrt[i] = (n < 4) ? F.in[19][k * 4 + n] : F.in[21][k * 32 + (n - 4)]; }
}

__device__ __forceinline__ void phase_p0b(Frame& F) {
    float* mod = (float*)(F.ws + WS_MOD);
    for (int i = blockIdx.x * 512 + F.tid; i < NB * NMOD; i += gridDim.x * 512) mod[i] = mod_at(F, i / NMOD, i % NMOD);
    LAS float* gm = (LAS float*)F.lds; LAS float* sh = gm + D;
    const float* x = F.in[0]; bf16_t* H = (bf16_t*)(F.ws + WS_H);
    for (int tile = blockIdx.x; tile < T / 256; tile += gridDim.x) {
        const int b = tile / 32;
        __syncthreads();
        for (int k = F.tid; k < D; k += 512) { gm[k] = F.in[4][k] * (1.0f + mod_at(F, b, D + k)); sh[k] = mod_at(F, b, k); }
        __syncthreads();
        for (int r = F.wave; r < 256; r += 8) {
            const size_t row = (size_t)tile * 256 + r;
            const f32x4* xr = (const f32x4*)(x + row * D) + F.lane;
            f32x4 v[4]; float s = 0.f;
#pragma unroll
            for (int j = 0; j < 4; ++j) { v[j] = xr[64 * j]; s += (v[j].x * v[j].x + v[j].y * v[j].y) + (v[j].z * v[j].z + v[j].w * v[j].w); }
            const float rstd = rsqrtf(wave_sum(s) * (1.0f / D) + EPS);
            u32x2* o = (u32x2*)(H + row * D) + F.lane;
#pragma unroll
            for (int j = 0; j < 4; ++j) { const int k = 4 * F.lane + 256 * j; const f32x4 g = *(const LAS f32x4*)(gm + k), sv = *(const LAS f32x4*)(sh + k);
                const f32x4 h = v[j] * rstd * g + sv; u32x2 w; w.x = pk2(h.x, h.y); w.y = pk2(h.z, h.w); o[64 * j] = w; }
        }
    }
}

__device__ __forceinline__ void phase_route(Frame& F) {
    const float* mod = (const float*)(F.ws + WS_MOD); const bf16_t* X1 = (const bf16_t*)(F.ws + WS_X1); bf16_t* H2 = (bf16_t*)(F.ws + WS_H);
    const float* wrt = (const float*)(F.ws + WS_WRT);
    int* tokE = (int*)(F.ws + WS_TOKE); float* tokW = (float*)(F.ws + WS_TOKW); int* bcnt = (int*)(F.ws + WS_BCNT);
    LAS float* gm = (LAS float*)F.lds; LAS float* sh = gm + D; LAS int* cnt = (LAS int*)(sh + D);
    for (int tile = blockIdx.x; tile < T / 256; tile += gridDim.x) {
        const int b = tile / 32;
        __syncthreads();
        for (int k = F.tid; k < D; k += 512) { gm[k] = F.in[5][k] * (1.0f + mod[(size_t)b * NMOD + 4 * D + k]); sh[k] = mod[(size_t)b * NMOD + 3 * D + k]; }
        if (F.tid < NE) cnt[F.tid] = 0;
        __syncthreads();
        for (int r = F.wave; r < 256; r += 8) {
            const size_t row = (size_t)tile * 256 + r;
            const u32x2* xr = (const u32x2*)(X1 + row * D) + F.lane;
            f32x4 v[4]; float s = 0.f;
#pragma unroll
            for (int j = 0; j < 4; ++j) { const u32x2 w = xr[64 * j]; v[j] = (f32x4){bflo(w.x), bfhi(w.x), bflo(w.y), bfhi(w.y)}; s += (v[j].x * v[j].x + v[j].y * v[j].y) + (v[j].z * v[j].z + v[j].w * v[j].w); }
            const float rstd = rsqrtf(wave_sum(s) * (1.0f / D) + EPS);
            u32x2* o = (u32x2*)(H2 + row * D) + F.lane;
#pragma unroll
            for (int j = 0; j < 4; ++j) { const int k = 4 * F.lane + 256 * j; const f32x4 g = *(const LAS f32x4*)(gm + k), sv = *(const LAS f32x4*)(sh + k);
                v[j] = v[j] * rstd * g + sv; u32x2 w; w.x = pk2(v[j].x, v[j].y); w.y = pk2(v[j].z, v[j].w); o[64 * j] = w; }
            LAS float* lgs = (LAS float*)(cnt + 32) + F.wave * 48;
#pragma unroll 2
            for (int n = 0; n < 36; ++n) { float p = 0.f;
#pragma unroll
                for (int j = 0; j < 4; ++j) { const f32x4 w = *(const f32x4*)(wrt + (size_t)n * D + 4 * F.lane + 256 * j); p += (v[j].x * w.x + v[j].y * w.y) + (v[j].z * w.z + v[j].w * w.w); }
                p = wave_sum(p); if (F.lane == 0) lgs[n] = p; }
            asm volatile("s_waitcnt lgkmcnt(0)" ::: "memory");
            float cl[4];
#pragma unroll
            for (int j = 0; j < 4; ++j) cl[j] = lgs[j] + F.in[20][j];
            int grp = 0; float cm = cl[0];
#pragma unroll
            for (int j = 1; j < 4; ++j) if (cl[j] > cm) { cm = cl[j]; grp = j; }
            float den = 0.f;
#pragma unroll
            for (int j = 0; j < 4; ++j) den += __expf(cl[j] - cm);
            const float pg = 1.0f / den;
            float fl[8];
#pragma unroll
            for (int j = 0; j < 8; ++j) fl[j] = lgs[4 + 8 * grp + j] + F.in[22][grp * 8 + j];
            int i1 = 0; float m1 = fl[0];
#pragma unroll
            for (int j = 1; j < 8; ++j) if (fl[j] > m1) { m1 = fl[j]; i1 = j; }
            int i2 = -1; float m2 = -3.0e38f;
#pragma unroll
            for (int j = 0; j < 8; ++j) if (j != i1 && fl[j] > m2) { m2 = fl[j]; i2 = j; }
            const float e21 = __expf(m2 - m1), inv = 1.0f / (1.0f + e21);
            if (F.lane == 0) {
                tokE[row * 2] = grp * 8 + i1; tokE[row * 2 + 1] = grp * 8 + i2;
                tokW[row * 2] = pg * inv; tokW[row * 2 + 1] = pg * e21 * inv;
                atomicAdd((int*)(cnt + grp * 8 + i1), 1); atomicAdd((int*)(cnt + grp * 8 + i2), 1);
            }
        }
        __syncthreads();
        if (F.tid < NE) bcnt[tile * NE + F.tid] = cnt[F.tid];
    }
}

__device__ __forceinline__ void phase_slots(Frame& F) {
    const int* tokE = (const int*)(F.ws + WS_TOKE); const float* tokW = (const float*)(F.ws + WS_TOKW); const int* bcnt = (const int*)(F.ws + WS_BCNT);
    int* tokS = (int*)(F.ws + WS_TOKS); int* slotT = (int*)(F.ws + WS_SLOTT); float* slotW = (float*)(F.ws + WS_SLOTW);
    LAS int* tot = (LAS int*)F.lds; LAS int* base = tot + 32; LAS int* seg = base + 32; LAS int* el = seg + 64; LAS int* rk = el + 512;
    for (int tile = blockIdx.x; tile < T / 256; tile += gridDim.x) {
        __syncthreads();
        if (F.tid < NE) { int t_ = 0, b_ = 0; for (int q = 0; q < T / 256; ++q) { const int c = bcnt[q * NE + F.tid]; t_ += c; if (q < tile) b_ += c; } tot[F.tid] = t_; base[F.tid] = b_; }
        el[F.tid] = tokE[(size_t)tile * 512 + F.tid];
        __syncthreads();
        if (F.tid == 0) { int s = 0; for (int e = 0; e < NE; ++e) { seg[e] = s; s += (tot[e] + 255) & ~255; } seg[NE] = s; }
        if (F.tid < NE) { int r = 0; for (int i = 0; i < 512; ++i) if (el[i] == F.tid) { rk[i] = r; ++r; } }
        __syncthreads();
        { const int e = el[F.tid], slot = seg[e] + base[e] + rk[F.tid]; const size_t a = (size_t)tile * 512 + F.tid;
          slotT[slot] = (int)(a >> 1); slotW[slot] = tokW[a]; tokS[a] = slot; }
        if (tile < NE) { const int e = tile; for (int s = seg[e] + tot[e] + F.tid; s < seg[e + 1]; s += 512) { slotT[s] = 0; slotW[s] = 0.f; } }
    }
}

__device__ __forceinline__ int moe_tiles(Frame& F, LAS int* tileE, LAS int* tileRow, LAS int* tmp) {
    const int* bcnt = (const int*)(F.ws + WS_BCNT);
    __syncthreads();
    if (F.tid < NE) { int t_ = 0; for (int q = 0; q < T / 256; ++q) t_ += bcnt[q * NE + F.tid]; tmp[F.tid] = t_; }
    __syncthreads();
    if (F.tid == 0) { int n = 0, s = 0; for (int e = 0; e < NE; ++e) { const int nt = (tmp[e] + 255) >> 8; for (int q = 0; q < nt; ++q) { tileE[n] = e; tileRow[n] = s + q * 256; ++n; } s += nt * 256; } tmp[32] = n; }
    __syncthreads();
    return tmp[32];
}


__device__ __forceinline__ void phase_final(Frame& F) {
    const float* mod = (const float*)(F.ws + WS_MOD); const bf16_t* X1 = (const bf16_t*)(F.ws + WS_X1); const bf16_t* O = (const bf16_t*)(F.ws + WS_PROJ);
    const int* tokS = (const int*)(F.ws + WS_TOKS); const float* gf = F.in[6];
    const int gw = blockIdx.x * 8 + F.wave, NGW = gridDim.x * 8;
    for (int row = gw; row < T; row += NGW) {
        const int b = row / SEQ; const int s0 = tokS[(size_t)row * 2], s1 = tokS[(size_t)row * 2 + 1];
        const u32x2* xr = (const u32x2*)(X1 + (size_t)row * D) + F.lane; const u32x2* o0 = (const u32x2*)(O + (size_t)s0 * D) + F.lane; const u32x2* o1 = (const u32x2*)(O + (size_t)s1 * D) + F.lane;
        const float* gt = mod + (size_t)b * NMOD + 5 * D;
        f32x4 v[4]; float s = 0.f;
#pragma unroll
        for (int j = 0; j < 4; ++j) { const u32x2 w = xr[64 * j], a = o0[64 * j], c = o1[64 * j]; const f32x4 g = *(const f32x4*)(gt + 4 * F.lane + 256 * j);
            v[j] = (f32x4){bflo(w.x) + g.x * (bflo(a.x) + bflo(c.x)), bfhi(w.x) + g.y * (bfhi(a.x) + bfhi(c.x)), bflo(w.y) + g.z * (bflo(a.y) + bflo(c.y)), bfhi(w.y) + g.w * (bfhi(a.y) + bfhi(c.y))};
            s += (v[j].x * v[j].x + v[j].y * v[j].y) + (v[j].z * v[j].z + v[j].w * v[j].w); }
        const float rstd = rsqrtf(wave_sum(s) * (1.0f / D) + EPS);
        f32x4* op = (f32x4*)(F.out + (size_t)row * D) + F.lane;
#pragma unroll
        for (int j = 0; j < 4; ++j) { const f32x4 g = *(const f32x4*)(gf + 4 * F.lane + 256 * j); op[64 * j] = v[j] * rstd * g; }
    }
}

enum { PH_P0A = 0, PH_P0B, PH_PROJ, PH_MIX_A, PH_MIX_B, PH_MIX_C, PH_OUT, PH_ROUTE, PH_SLOTS, PH_MOE1, PH_MOE2, PH_FINAL, PH_N };

__global__ void __launch_bounds__(512, 2) fwd(Args args) {
    extern __shared__ __attribute__((aligned(16))) unsigned char lds_raw[];
    Frame F; F.lds = (LAS unsigned char*)lds_raw; F.tid = threadIdx.x; F.lane = F.tid & 63; F.wave = __builtin_amdgcn_readfirstlane(F.tid >> 6);
    F.in = args.in; F.ws = args.ws; F.out = args.out;
    const int lo = args.ph_lo, hi = args.ph_hi;
#define IN(k) (lo <= (k) && (k) < hi)
    if (IN(PH_P0A)) phase_p0a(F);
    if (IN(PH_P0B)) phase_p0b(F);
    if (IN(PH_PROJ)) {
        DenseSched S{(const bf16_t*)(F.ws + WS_H), (const bf16_t*)(F.ws + WS_WIN), D, T / 256, NPROJ / 256, (int)gridDim.x, (int)blockIdx.x};
        EpiProj E{(bf16_t*)(F.ws + WS_PROJ), F.in[16]};
        gemm_simple(S, E);
    }
    if (IN(PH_OUT)) {
        DenseSched S{(const bf16_t*)(F.ws + WS_H), (const bf16_t*)(F.ws + WS_WOUT), D, T / 256, D / 256, (int)gridDim.x, (int)blockIdx.x};
        EpiX1 E{(bf16_t*)(F.ws + WS_X1), F.in[0], (const float*)(F.ws + WS_MOD)};
        gemm_simple(S, E);
    }
    if (IN(PH_ROUTE)) phase_route(F);
    if (IN(PH_SLOTS)) phase_slots(F);
    if (IN(PH_MOE1)) {
        LAS int* tileE = (LAS int*)(F.lds + 140000); LAS int* tileRow = tileE + 640; LAS int* tmp = tileRow + 640;
        const int nt = moe_tiles(F, tileE, tileRow, tmp);
        MoeSched S{(const bf16_t*)(F.ws + WS_H), (const bf16_t*)(F.ws + WS_WGU), (const int*)(F.ws + WS_SLOTT), D, true, (size_t)D * D, tileE, tileRow, nt, (int)gridDim.x, (int)blockIdx.x};
        EpiSwiglu E{(bf16_t*)(F.ws + WS_KVT)};
        gemm_simple(S, E);
    }
    if (IN(PH_MOE2)) {
        LAS int* tileE = (LAS int*)(F.lds + 140000); LAS int* tileRow = tileE + 640; LAS int* tmp = tileRow + 640;
        const int nt = moe_tiles(F, tileE, tileRow, tmp);
        MoeSched S{(const bf16_t*)(F.ws + WS_KVT), (const bf16_t*)(F.ws + WS_WD), (const int*)(F.ws + WS_SLOTT), DE, false, (size_t)D * DE, tileE, tileRow, nt, (int)gridDim.x, (int)blockIdx.x};
        EpiDown E{(bf16_t*)(F.ws + WS_PROJ), (const float*)(F.ws + WS_SLOTW)};
        gemm_simple(S, E);
    }
    if (IN(PH_FINAL)) phase_final(F);
#undef IN
}

__global__ void __launch_bounds__(256) k_lru_au(const bf16_t* P, const float* conv_w, const float* conv_b, const float* wr, const float* br, const float* wi, const float* bi, const float* lam, float* A_, float* U_) {
    __shared__ float xs[4][64];
    const int h = blockIdx.y, tl = threadIdx.x >> 6, j = threadIdx.x & 63, ch = h * 64 + j; const int t = blockIdx.x * 4 + tl, pos = t % SEQ;
    float xc = conv_b[ch];
#pragma unroll
    for (int k = 0; k < 4; ++k) { const int p = pos - 3 + k; if (p >= 0) xc += conv_w[k * DL + ch] * bf2f(P[(size_t)(t - 3 + k) * NPROJ + C_LX + ch]); }
    xs[tl][j] = xc; __syncthreads();
    float r = br[ch], g = bi[ch];
    for (int i = 0; i < 64; ++i) { const float xv = xs[tl][i]; r += xv * wr[(h * 64 + i) * 64 + j]; g += xv * wi[(h * 64 + i) * 64 + j]; }
    r = sigmoidf_(r); g = sigmoidf_(g);
    const float nl = -lam[ch], sp = fmaxf(nl, 0.f) + log1pf(expf(-fabsf(nl)));
    const float la = -8.0f * r * sp;
    A_[(size_t)t * DL + ch] = expf(la);
    U_[(size_t)t * DL + ch] = sqrtf(-expm1f(2.0f * la)) * (g * xc);
}
__global__ void __launch_bounds__(64) k_lru_scan(const float* A_, const float* U_, const bf16_t* P, bf16_t* MIX) {
    const int g = blockIdx.x * 64 + threadIdx.x, b = g / DL, ch = g % DL;
    float h = 0.f;
    for (int t0 = 0; t0 < SEQ; t0 += 8) {
        float a[8], u[8], y[8];
#pragma unroll
        for (int q = 0; q < 8; ++q) { const size_t t = (size_t)b * SEQ + t0 + q; a[q] = A_[t * DL + ch]; u[q] = U_[t * DL + ch]; y[q] = bf2f(P[t * NPROJ + C_LY + ch]); }
#pragma unroll
        for (int q = 0; q < 8; ++q) { h = a[q] * h + u[q]; MIX[((size_t)b * SEQ + t0 + q) * D + ch] = (bf16_t)f2bf(h * gelu_tanh(y[q])); }
    }
}
__global__ void __launch_bounds__(128) k_gla_naive(const bf16_t* P, const float* gnorm, bf16_t* MIX) {
    __shared__ float al[8][64], ks[8][64], qs[8][64], red[8][2];
    const int b = blockIdx.x / GH, h = blockIdx.x % GH, e = threadIdx.x;
    float St[64];
#pragma unroll
    for (int d = 0; d < 64; ++d) St[d] = 0.f;
    const float gn = gnorm[e];
    for (int t0 = 0; t0 < SEQ; t0 += 8) {
        __syncthreads();
        for (int i = threadIdx.x; i < 512; i += 128) { const int q = i >> 6, d = i & 63; const size_t row = ((size_t)b * SEQ + t0 + q) * NPROJ;
            al[q][d] = expf(bf2f(P[row + C_LA + h * 64 + d])); ks[q][d] = bf2f(P[row + C_K + h * 64 + d]); qs[q][d] = bf2f(P[row + C_Q + h * 64 + d]) * 0.125f; }
        float v[8], gt[8], o[8];
#pragma unroll
        for (int q = 0; q < 8; ++q) { const size_t row = ((size_t)b * SEQ + t0 + q) * NPROJ; v[q] = bf2f(P[row + C_V + h * 128 + e]); gt[q] = bf2f(P[row + C_G + h * 128 + e]); }
        __syncthreads();
#pragma unroll
        for (int q = 0; q < 8; ++q) { float acc = 0.f;
#pragma unroll
            for (int d = 0; d < 64; ++d) { St[d] = al[q][d] * St[d] + ks[q][d] * v[q]; acc += qs[q][d] * St[d]; }
            o[q] = acc; const float ss = wave_sum(acc * acc); if ((threadIdx.x & 63) == 0) red[q][threadIdx.x >> 6] = ss; }
        __syncthreads();
#pragma unroll
        for (int q = 0; q < 8; ++q) { const float ms = (red[q][0] + red[q][1]) * (1.0f / 128.0f); const float y = o[q] * rsqrtf(ms + EPS) * gn * siluf_(gt[q]);
            MIX[((size_t)b * SEQ + t0 + q) * D + DL + h * 128 + e] = (bf16_t)f2bf(y); }
    }
}

extern "C" void kernel_launch(void* const* d_in, const int* in_sizes, int n_in, void* d_out, int out_size, void* d_ws, size_t ws_size, hipStream_t stream) {
    static int grid = 0;
    if (grid == 0) {
        if (n_in != 26 || in_sizes[0] != T * D || out_size != T * D || ws_size < WS_END) { fprintf(stderr, "kernel_launch: unexpected shapes (n_in %d, in0 %d, out %d, ws %zu)\n", n_in, n_in > 0 ? in_sizes[0] : -1, out_size, ws_size); grid = -1; return; }
        int dev = 0, cus = 0;
        if (hipGetDevice(&dev) != hipSuccess || hipDeviceGetAttribute(&cus, hipDeviceAttributeMultiprocessorCount, dev) != hipSuccess) { grid = -1; return; }
        if (hipFuncSetAttribute((const void*)fwd, hipFuncAttributeMaxDynamicSharedMemorySize, LDS_BYTES) != hipSuccess) { fprintf(stderr, "kernel_launch: hipFuncSetAttribute failed\n"); grid = -1; return; }
        (void)hipGetLastError();
        grid = cus > 0 ? cus : 256;
    }
    if (grid < 0) return;
    hipMemsetAsync((char*)d_ws + WS_CTL, 0, CTL_BYTES, stream);
    Args a{};
    for (int i = 0; i < 26; ++i) a.in[i] = (const float*)d_in[i];
    a.out = (float*)d_out; a.ws = (unsigned char*)d_ws;
    unsigned char* ws = (unsigned char*)d_ws;
    auto run = [&](int lo, int hi) { a.ph_lo = lo; a.ph_hi = hi; hipLaunchKernelGGL(fwd, dim3(grid), dim3(512), LDS_BYTES, stream, a); };
    run(PH_P0A, PH_P0A + 1);
    run(PH_P0B, PH_P0B + 1);
    run(PH_PROJ, PH_PROJ + 1);
    hipLaunchKernelGGL(k_lru_au, dim3(T / 4, LH), dim3(256), 0, stream, (const bf16_t*)(ws + WS_PROJ), (const float*)d_in[8], (const float*)d_in[9], (const float*)d_in[10], (const float*)d_in[11],
                       (const float*)d_in[12], (const float*)d_in[13], (const float*)d_in[14], (float*)(ws + WS_NA), (float*)(ws + WS_NU));
    hipLaunchKernelGGL(k_lru_scan, dim3(NB * DL / 64), dim3(64), 0, stream, (const float*)(ws + WS_NA), (const float*)(ws + WS_NU), (const bf16_t*)(ws + WS_PROJ), (bf16_t*)(ws + WS_H));
    hipLaunchKernelGGL(k_gla_naive, dim3(NB * GH), dim3(128), 0, stream, (const bf16_t*)(ws + WS_PROJ), (const float*)d_in[17], (bf16_t*)(ws + WS_H));
    run(PH_OUT, PH_OUT + 1);
    run(PH_ROUTE, PH_ROUTE + 1);
    run(PH_SLOTS, PH_SLOTS + 1);
    run(PH_MOE1, PH_MOE1 + 1);
    run(PH_MOE2, PH_MOE2 + 1);
    run(PH_FINAL, PH_FINAL + 1);
}
```

```cpp
#include <hip/hip_runtime.h>
#include <cstdio>
#include <cstdint>

#define GAS __attribute__((address_space(1)))
#define LAS __attribute__((address_space(3)))
typedef unsigned short bf16_t;
typedef short bf16x8 __attribute__((ext_vector_type(8)));
typedef float f32x4 __attribute__((ext_vector_type(4)));
typedef float f32x2 __attribute__((ext_vector_type(2)));
typedef unsigned u32x4 __attribute__((ext_vector_type(4)));
typedef unsigned u32x2 __attribute__((ext_vector_type(2)));

constexpr int NB = 8, SEQ = 8192, T = NB * SEQ, D = 1024;
constexpr int DL = 512, LH = 8, LHD = 64;
constexpr int GH = 4, GDK = 64, GDV = 128;
constexpr int NE = 32, DE = 512;
constexpr int NIN = 2576;
constexpr int NPROJ = 2816;
constexpr int C_LX = 0, C_LY = 512, C_Q = 1024, C_K = 1280, C_V = 1536, C_G = 2048, C_LA = 2560;
constexpr int NMOD = 6 * D;
constexpr int NGRP = 2;
constexpr int NTG = (T / 256) / NGRP;
constexpr int SLOTS_G = 2 * (T / NGRP) + NE * 256;
constexpr int MAXSLOT = NGRP * SLOTS_G;
constexpr float EPS = 1e-6f;

constexpr size_t MiB = 1u << 20;
constexpr size_t WS_CTL = 0, CTL_BYTES = 1 * MiB;
constexpr size_t WS_MODP = 1 * MiB;
constexpr size_t WS_MOD = 4 * MiB;
constexpr size_t WS_WIN = 5 * MiB;
constexpr size_t WS_WOUT = 11 * MiB;
constexpr size_t WS_WGU = 13 * MiB;
constexpr size_t WS_WD = 77 * MiB;
constexpr size_t WS_WRT = 109 * MiB;
constexpr size_t WS_LRUW = 109 * MiB + 256 * 1024;
constexpr size_t WS_LSUM = 110 * MiB;
constexpr size_t WS_TOKE = 111 * MiB;
constexpr size_t WS_TOKW = 112 * MiB;
constexpr size_t WS_TOKS = 113 * MiB;
constexpr size_t WS_BCNT = 114 * MiB;
constexpr size_t WS_SLOTT = 115 * MiB;
constexpr size_t WS_SLOTW = 116 * MiB;
constexpr size_t WS_SS = 118 * MiB;
constexpr size_t WS_H = 128 * MiB;
constexpr size_t WS_PROJ = 256 * MiB;
constexpr size_t WS_X1 = 608 * MiB;
constexpr size_t WS_GRP = 736 * MiB, GRP_BYTES = 72 * MiB;
constexpr size_t WS_DEC = 936 * MiB;
constexpr size_t PROJ_GRP_BYTES = (size_t)(T / NGRP) * NPROJ * 2;
constexpr size_t WS_END = 992 * MiB;
static_assert(WS_GRP + NGRP * GRP_BYTES <= WS_DEC && (size_t)SLOTS_G * DE * 2 <= GRP_BYTES && (size_t)SLOTS_G * D * 2 <= PROJ_GRP_BYTES, "workspace map");

constexpr int LDS_BYTES = 147456;

__device__ __forceinline__ unsigned f2bf(float f) { return (unsigned)__builtin_bit_cast(unsigned short, (__bf16)f); }
typedef __bf16 bf16v2 __attribute__((ext_vector_type(2)));
__device__ __forceinline__ unsigned pk2(float lo, float hi) { bf16v2 v = {(__bf16)lo, (__bf16)hi}; return __builtin_bit_cast(unsigned, v); }
__device__ __forceinline__ float bf2f(unsigned short b) { return __builtin_bit_cast(float, ((unsigned)b) << 16); }
__device__ __forceinline__ float bflo(unsigned w) { return __builtin_bit_cast(float, w << 16); }
__device__ __forceinline__ float bfhi(unsigned w) { return __builtin_bit_cast(float, w & 0xffff0000u); }
__device__ __forceinline__ float wave_sum(float v) {
#pragma unroll
    for (int o = 1; o < 64; o <<= 1) v += __shfl_xor(v, o);
    return v;
}
__device__ __forceinline__ float sigmoidf_(float x) { return __builtin_amdgcn_rcpf(1.0f + __builtin_amdgcn_exp2f(-1.4426950408889634f * x)); }
__device__ __forceinline__ float siluf_(float x) { return x * __builtin_amdgcn_rcpf(1.0f + __builtin_amdgcn_exp2f(-1.4426950408889634f * x)); }
__device__ __forceinline__ float gelu_tanh(float x) { const float u = -2.3022081985f * (x + 0.044715f * x * x * x); return x * __builtin_amdgcn_rcpf(1.0f + __builtin_amdgcn_exp2f(u)); }
__device__ __forceinline__ f32x4 mfma16(bf16x8 a, bf16x8 b, f32x4 c) { return __builtin_amdgcn_mfma_f32_16x16x32_bf16(a, b, c, 0, 0, 0); }
__device__ __forceinline__ void unpack8(const u32x4 w, float (&f)[8]) { f[0] = bflo(w.x); f[1] = bfhi(w.x); f[2] = bflo(w.y); f[3] = bfhi(w.y); f[4] = bflo(w.z); f[5] = bfhi(w.z); f[6] = bflo(w.w); f[7] = bfhi(w.w); }
__device__ __forceinline__ float logsig16(float z) { const float e = __builtin_amdgcn_exp2f(-1.4426950408889634f * fabsf(z)); return (fminf(z, 0.f) - 0.6931471805599453f * __builtin_amdgcn_logf(1.0f + e)) * 0.0625f; }
__host__ __device__ __forceinline__ int perm32(int rho) { const int n = rho >> 4, i = rho & 15; return 8 * (i >> 2) + 4 * n + (i & 3); }

struct Args { const float* in[26]; float* out; unsigned char* ws; };

struct Frame {
    LAS unsigned char* lds;
    int tid, lane, wave;
    const float* const* in;
    unsigned char* ws;
    float* out;
    int vb, vg, grp;
};

__device__ __forceinline__ bf16_t* grp_kvt(const Frame& F) { return (bf16_t*)(F.ws + WS_GRP + (size_t)F.grp * GRP_BYTES) - (size_t)F.grp * (NB / NGRP) * 128 * GH * 8192; }
__device__ __forceinline__ bf16_t* grp_st(const Frame& F) { return (bf16_t*)(F.ws + WS_GRP + (size_t)F.grp * GRP_BYTES + 32 * MiB) - (size_t)F.grp * (NB / NGRP) * 128 * GH * 8192; }
__device__ __forceinline__ bf16_t* grp_hid(const Frame& F) { return (bf16_t*)(F.ws + WS_GRP + (size_t)F.grp * GRP_BYTES) - (size_t)F.grp * SLOTS_G * DE; }
__device__ __forceinline__ bf16_t* grp_o(const Frame& F) { return (bf16_t*)(F.ws + WS_PROJ + (size_t)F.grp * PROJ_GRP_BYTES) - (size_t)F.grp * SLOTS_G * D; }

struct Unit { int pm, pn, e, row0; };

constexpr int BM = 256, BK = 64, HALF = 128, HTB = HALF * BK * 2, STAGE_BYTES = 8 * HTB;
__host__ __device__ __forceinline__ int lds_byte(int r, int c) { const int st = (r >> 4) * 2 + (c >> 5), rr = r & 15, cc = c & 31, ob = rr * 64 + cc * 2; return st * 1024 + (ob ^ (((ob >> 9) & 1) << 5)); }
__host__ __device__ __forceinline__ void stage_rc(int b, int& R, int& C) { const int st = b / 1024, sb = b % 1024, swz = sb ^ (((sb >> 9) & 1) << 5); R = (st >> 1) * 16 + swz / 64; C = (st & 1) * 32 + (swz % 64) / 2; }

template <class Epi, class Sched, bool GATHER>
__device__ __forceinline__ void gemm_fast(LAS unsigned char* lds, const Sched& S, const Epi& E) {
    int tid = threadIdx.x; asm volatile("" : "+v"(tid));
    const int wid = __builtin_amdgcn_readfirstlane(tid >> 6), lane = tid & 63, wr = wid >> 2, wc = wid & 3, fr = lane & 15, fq = lane >> 4;
    const int K = S.K, nt = K / BK;
    unsigned voffA[2], voffB[2]; int RA[2];
#pragma unroll
    for (int i = 0; i < 2; ++i) { int R, C; stage_rc(tid * 16 + i * 8192, R, C); const int Rb = Epi::PERM ? ((R & ~31) + perm32(R & 31)) : R;
        RA[i] = R; voffA[i] = GATHER ? (unsigned)(C * 2) : (unsigned)(R * K + C) * 2u; voffB[i] = (unsigned)(Rb * K + C) * 2u; }
    const size_t kstep = (size_t)(BK * 2);
    const size_t hstep = (size_t)HALF * K * 2;
    const unsigned ldsw = (unsigned)wid * 1024u;
    const int aoff = lds_byte(wr * 64 + fr, fq * 8), boff = lds_byte(wc * 32 + fr, fq * 8);
#define PG8_SA(b, h) (((b) * 2 + (h)) * HTB)
#define PG8_SB(b, h) ((4 + (b) * 2 + (h)) * HTB)
#define PG8_STAGE(bufoff, gbase, voff) do { _Pragma("unroll") for (int _i = 0; _i < 2; ++_i) \
        __builtin_amdgcn_global_load_lds((const unsigned*)((const char*)(gbase) + (voff)[_i]), (LAS unsigned*)(lds + (bufoff) + ldsw + _i * 8192), 16, 0, 0); } while (0)
#define PG8_STAGE_A(bufoff, gbase, h, ov) do { if constexpr (GATHER) { \
        __builtin_amdgcn_global_load_lds((const unsigned*)((const char*)(gbase) + (ov)[h][0]), (LAS unsigned*)(lds + (bufoff) + ldsw), 16, 0, 0); \
        __builtin_amdgcn_global_load_lds((const unsigned*)((const char*)(gbase) + (ov)[h][1]), (LAS unsigned*)(lds + (bufoff) + ldsw + 8192), 16, 0, 0); } \
      else { PG8_STAGE(bufoff, (gbase) + (h) * hstep, voffA); } } while (0)
#define PG8_LDA(dst, b, h) do { _Pragma("unroll") for (int m = 0; m < 4; ++m) _Pragma("unroll") for (int k = 0; k < 2; ++k) dst[m][k] = *(const LAS bf16x8*)(lds + PG8_SA(b, h) + aoff + m * 2048 + k * 1024); } while (0)
#define PG8_LDB(dst, b, h) do { _Pragma("unroll") for (int n = 0; n < 2; ++n) _Pragma("unroll") for (int k = 0; k < 2; ++k) dst[n][k] = *(const LAS bf16x8*)(lds + PG8_SB(b, h) + boff + n * 2048 + k * 1024); } while (0)
#define PG8_MMA(ai, bj, At, Bt) do { __builtin_amdgcn_s_setprio(1); _Pragma("unroll") for (int m = 0; m < 4; ++m) _Pragma("unroll") for (int n = 0; n < 2; ++n) _Pragma("unroll") for (int k = 0; k < 2; ++k) \
        acc[ai][bj][m][n] = __builtin_amdgcn_mfma_f32_16x16x32_bf16(Bt[n][k], At[m][k], acc[ai][bj][m][n], 0, 0, 0); __builtin_amdgcn_s_setprio(0); } while (0)
#define PG8_WAIT_V(n) asm volatile("s_waitcnt vmcnt(" #n ")" ::: "memory")
#define PG8_WAIT_L(n) asm volatile("s_waitcnt lgkmcnt(" #n ")" ::: "memory")
#define PG8_BAR __builtin_amdgcn_s_barrier()
#define PG8_SCHED __builtin_amdgcn_sched_barrier(0)
    Unit cur, nxt; int ui = 0;
    if (!S.next(0, cur)) return;
    f32x4 acc[2][2][4][2];
#pragma unroll
    for (int a = 0; a < 2; ++a)
#pragma unroll
        for (int b = 0; b < 2; ++b)
#pragma unroll
            for (int m = 0; m < 4; ++m)
#pragma unroll
                for (int n = 0; n < 2; ++n) acc[a][b][m][n] = (f32x4){0.f, 0.f, 0.f, 0.f};
    bf16x8 At[4][2], B0[2][2], B1[2][2];
    const char* cA = S.a_base(cur); const char* cB = S.b_base(cur);
    unsigned cv[2][2], nv[2][2];
    if constexpr (GATHER) {
#pragma unroll
        for (int h = 0; h < 2; ++h)
#pragma unroll
            for (int i = 0; i < 2; ++i) { cv[h][i] = S.a_rowoff(cur, h * HALF + RA[i]) + voffA[i]; nv[h][i] = cv[h][i]; }
    }
    PG8_STAGE(PG8_SB(0, 0), cB, voffB); PG8_STAGE(PG8_SB(0, 1), cB + hstep, voffB); PG8_STAGE_A(PG8_SA(0, 0), cA, 0, cv); PG8_STAGE_A(PG8_SA(0, 1), cA, 1, cv);
    if (wr == 1) PG8_BAR;
    PG8_WAIT_V(2); PG8_BAR;
    PG8_STAGE(PG8_SB(1, 0), cB + kstep, voffB); PG8_STAGE_A(PG8_SA(1, 0), cA + kstep, 0, cv); PG8_STAGE(PG8_SB(1, 1), cB + hstep + kstep, voffB);
    PG8_WAIT_V(6); PG8_BAR;
    for (;;) {
        const bool has_next = S.next(ui + 1, nxt);
        const char* nA = has_next ? S.a_base(nxt) : cA; const char* nB = has_next ? S.b_base(nxt) : cB;
        if constexpr (GATHER) {
            if (has_next) {
#pragma unroll
                for (int h = 0; h < 2; ++h)
#pragma unroll
                    for (int i = 0; i < 2; ++i) nv[h][i] = S.a_rowoff(nxt, h * HALF + RA[i]) + voffA[i];
            }
        }
        for (int t = 0; t < nt; t += 2) {
            const bool last = (t == nt - 2);
            const char* a1 = cA + (size_t)(t + 1) * kstep;
            const char* a2 = last ? nA : cA + (size_t)(t + 2) * kstep; const char* b2 = last ? nB : cB + (size_t)(t + 2) * kstep;
            const char* a3 = a2 + kstep; const char* b3 = b2 + kstep;
            unsigned lv[2][2];
            if constexpr (GATHER) {
#pragma unroll
                for (int h = 0; h < 2; ++h)
#pragma unroll
                    for (int i = 0; i < 2; ++i) lv[h][i] = last ? nv[h][i] : cv[h][i];
            }
            PG8_LDB(B0, 0, 0); PG8_LDB(B1, 0, 1); PG8_SCHED; PG8_LDA(At, 0, 0); PG8_STAGE_A(PG8_SA(1, 1), a1, 1, cv);
            PG8_WAIT_V(8); PG8_WAIT_L(0); PG8_BAR; PG8_MMA(0, 0, At, B0); PG8_MMA(0, 1, At, B1); PG8_BAR; PG8_SCHED;
            PG8_LDA(At, 0, 1); PG8_STAGE(PG8_SB(0, 0), b2, voffB); PG8_STAGE(PG8_SB(0, 1), b2 + hstep, voffB); PG8_STAGE_A(PG8_SA(0, 0), a2, 0, lv);
            PG8_WAIT_V(8); PG8_WAIT_L(0); PG8_BAR; PG8_MMA(1, 0, At, B0); PG8_MMA(1, 1, At, B1); PG8_BAR; PG8_SCHED;
            PG8_LDB(B0, 1, 0); PG8_LDB(B1, 1, 1); PG8_SCHED; PG8_LDA(At, 1, 0); PG8_STAGE_A(PG8_SA(0, 1), a2, 1, lv);
            PG8_WAIT_V(8); PG8_WAIT_L(0); PG8_BAR; PG8_MMA(0, 0, At, B0); PG8_MMA(0, 1, At, B1); PG8_BAR; PG8_SCHED;
            PG8_LDA(At, 1, 1); PG8_STAGE(PG8_SB(1, 0), b3, voffB); PG8_STAGE(PG8_SB(1, 1), b3 + hstep, voffB); PG8_STAGE_A(PG8_SA(1, 0), a3, 0, lv);
            PG8_WAIT_V(8); PG8_WAIT_L(0); PG8_BAR; PG8_MMA(1, 0, At, B0); PG8_MMA(1, 1, At, B1); PG8_BAR; PG8_SCHED;
        }
        if (wr == 0) PG8_BAR;
        E(acc, cur, wr, wc, fr, fq);
        if (!has_next) break;
#pragma unroll
        for (int a = 0; a < 2; ++a)
#pragma unroll
            for (int b = 0; b < 2; ++b)
#pragma unroll
                for (int m = 0; m < 4; ++m)
#pragma unroll
                    for (int n = 0; n < 2; ++n) acc[a][b][m][n] = (f32x4){0.f, 0.f, 0.f, 0.f};
        cur = nxt; cA = nA; cB = nB; ++ui;
        if constexpr (GATHER) {
#pragma unroll
            for (int h = 0; h < 2; ++h)
#pragma unroll
                for (int i = 0; i < 2; ++i) cv[h][i] = nv[h][i];
        }
        if (wr == 1) PG8_BAR;
    }
    PG8_WAIT_V(0);
    PG8_BAR;
#undef PG8_SA
#undef PG8_SB
#undef PG8_STAGE
#undef PG8_STAGE_A
#undef PG8_LDA
#undef PG8_LDB
#undef PG8_MMA
#undef PG8_WAIT_V
#undef PG8_WAIT_L
#undef PG8_BAR
#undef PG8_SCHED
}

struct DenseFast {
    const bf16_t* A; const bf16_t* Bt; int K, nM, nN, G, c, pm0;
    __device__ __forceinline__ bool next(int i, Unit& u) const {
        const int nwg = nM * nN; const long L = (long)i * G + c; if (L >= nwg) return false;
        int wgid = (int)L; { const int q = nwg / 8, r = nwg % 8, xcd = wgid % 8, off = wgid / 8; wgid = (xcd < r ? xcd * (q + 1) : r * (q + 1) + (xcd - r) * q) + off; }
        const int nig = 8 * nN, gid = wgid / nig, fm = gid * 8, gsz = (nM - fm) < 8 ? (nM - fm) : 8;
        u.pm = pm0 + fm + ((wgid % nig) % gsz); u.pn = (wgid % nig) / gsz; u.e = 0; u.row0 = u.pm * 256; return true;
    }
    __device__ __forceinline__ const char* a_base(const Unit& u) const { return (const char*)(A + (size_t)u.pm * 256 * K); }
    __device__ __forceinline__ const char* b_base(const Unit& u) const { return (const char*)(Bt + (size_t)u.pn * 256 * K); }
    __device__ __forceinline__ unsigned a_rowoff(const Unit&, int) const { return 0u; }
};
struct MoeFast {
    const bf16_t* A; const bf16_t* Bt; int K; size_t estride;
    LAS int* tileE; LAS int* tileRow; LAS unsigned* rowoff; int ntiles, G, c;
    __device__ __forceinline__ int unit_id(int i) const {
        const int nwg = ntiles * 4; const long L = (long)i * G + c; if (L >= nwg) return -1;
        const int q = nwg / 8, r = nwg % 8, xcd = (int)(L % 8), off = (int)(L / 8); return (xcd < r ? xcd * (q + 1) : r * (q + 1) + (xcd - r) * q) + off;
    }
    __device__ __forceinline__ bool next(int i, Unit& u) const { const int w = unit_id(i); if (w < 0) return false; u.pm = w >> 2; u.pn = w & 3; u.e = tileE[u.pm]; u.row0 = tileRow[u.pm]; u.e |= i << 8; return true; }
    __device__ __forceinline__ const char* a_base(const Unit& u) const { return rowoff ? (const char*)A : (const char*)(A + (size_t)u.row0 * K); }
    __device__ __forceinline__ const char* b_base(const Unit& u) const { return (const char*)(Bt + (size_t)(u.e & 255) * estride + (size_t)u.pn * 256 * K); }
    __device__ __forceinline__ unsigned a_rowoff(const Unit& u, int r) const { return rowoff[(u.e >> 8) * 256 + r]; }
};

__device__ __forceinline__ u32x4 pack8(f32x4 v0, f32x4 v1) { u32x4 w; w.x = pk2(v0[0], v0[1]); w.y = pk2(v0[2], v0[3]); w.z = pk2(v1[0], v1[1]); w.w = pk2(v1[2], v1[3]); return w; }

struct EpiProj {
    static constexpr bool PERM = true;
    bf16_t* P; const float* ba;
    __device__ __forceinline__ void operator()(const f32x4 (&acc)[2][2][4][2], const Unit& u, int wr, int wc, int fr, int fq) const {
        const int row0 = u.pm * 256 + wr * 64 + fr, col0 = u.pn * 256 + wc * 32 + 8 * fq;
#pragma unroll
        for (int ai = 0; ai < 2; ++ai)
#pragma unroll
            for (int m = 0; m < 4; ++m) { bf16_t* rowp = P + (size_t)(row0 + ai * 128 + m * 16) * NPROJ + col0;
#pragma unroll
                for (int bj = 0; bj < 2; ++bj) { f32x4 v0 = acc[ai][bj][m][0], v1 = acc[ai][bj][m][1];
                    if (u.pn == 10) { const float* bp = ba + (col0 + bj * 128 - C_LA);
#pragma unroll
                        for (int j = 0; j < 4; ++j) { float z = v0[j] + bp[j]; v0[j] = logsig16(z); z = v1[j] + bp[4 + j]; v1[j] = logsig16(z); } }
                    *(u32x4*)(rowp + bj * 128) = pack8(v0, v1); } }
    }
};
struct EpiX1 {
    static constexpr bool PERM = true;
    bf16_t* X1; const float* x; const float* mod; float* SS;
    __device__ __forceinline__ void operator()(const f32x4 (&acc)[2][2][4][2], const Unit& u, int wr, int wc, int fr, int fq) const {
        const int row0 = u.pm * 256 + wr * 64 + fr, col0 = u.pn * 256 + wc * 32 + 8 * fq;
        const float* gt = mod + (size_t)(u.pm / 32) * NMOD + 2 * D;
        f32x4 g0[2], g1[2];
#pragma unroll
        for (int bj = 0; bj < 2; ++bj) { g0[bj] = *(const f32x4*)(gt + col0 + bj * 128); g1[bj] = *(const f32x4*)(gt + col0 + bj * 128 + 4); }
#pragma unroll
        for (int ai = 0; ai < 2; ++ai)
#pragma unroll
            for (int m = 0; m < 4; ++m) { const int r = row0 + ai * 128 + m * 16; float s = 0.f;
#pragma unroll
                for (int bj = 0; bj < 2; ++bj) { const size_t o = (size_t)r * D + col0 + bj * 128;
                    const f32x4 x0 = __builtin_nontemporal_load((const f32x4*)(x + o)), x1 = __builtin_nontemporal_load((const f32x4*)(x + o + 4));
                    const u32x4 w = pack8(x0 + g0[bj] * acc[ai][bj][m][0], x1 + g1[bj] * acc[ai][bj][m][1]);
                    *(u32x4*)(X1 + o) = w;
                    float f[8]; unpack8(w, f);
#pragma unroll
                    for (int j = 0; j < 8; ++j) s += f[j] * f[j]; }
                s += __shfl_xor(s, 16); s += __shfl_xor(s, 32);
                if (fq == 0) SS[(size_t)r * 16 + u.pn * 4 + wc] = s; }
    }
};
struct EpiSwiglu {
    static constexpr bool PERM = true;
    bf16_t* HID;
    __device__ __forceinline__ void operator()(const f32x4 (&acc)[2][2][4][2], const Unit& u, int wr, int wc, int fr, int fq) const {
        const int row0 = u.row0 + wr * 64 + fr, col0 = u.pn * 128 + wc * 32 + 8 * fq;
#pragma unroll
        for (int ai = 0; ai < 2; ++ai)
#pragma unroll
            for (int m = 0; m < 4; ++m) { f32x4 h0, h1;
#pragma unroll
                for (int j = 0; j < 4; ++j) { h0[j] = siluf_(acc[ai][0][m][0][j]) * acc[ai][1][m][0][j]; h1[j] = siluf_(acc[ai][0][m][1][j]) * acc[ai][1][m][1][j]; }
                *(u32x4*)(HID + (size_t)(row0 + ai * 128 + m * 16) * DE + col0) = pack8(h0, h1); }
    }
};
struct EpiDown {
    static constexpr bool PERM = true;
    bf16_t* O; const float* slot_w;
    __device__ __forceinline__ void operator()(const f32x4 (&acc)[2][2][4][2], const Unit& u, int wr, int wc, int fr, int fq) const {
        const int row0 = u.row0 + wr * 64 + fr, col0 = u.pn * 256 + wc * 32 + 8 * fq;
#pragma unroll
        for (int ai = 0; ai < 2; ++ai)
#pragma unroll
            for (int m = 0; m < 4; ++m) { const int r = row0 + ai * 128 + m * 16; const float w = slot_w[r];
#pragma unroll
                for (int bj = 0; bj < 2; ++bj) *(u32x4*)(O + (size_t)r * D + col0 + bj * 128) = pack8(acc[ai][bj][m][0] * w, acc[ai][bj][m][1] * w); }
    }
};


#define XB_TMO      128
#define XB_XCNT(j)  (256  + 64 * (j))
#define XB_XSUB(j)  (1280 + 64 * (j))
#define XB_XGEN(j)  (2304 + 64 * (j))
#define XB_TOP      3328
#define XB_TOPGEN   3392
#define XCD_BAR_WORDS 3456
#define XB_SPIN_CAP (1u << 18)

__device__ __forceinline__ unsigned xb_ld(unsigned* p)              { return __hip_atomic_load(p, __ATOMIC_RELAXED, __HIP_MEMORY_SCOPE_AGENT); }
__device__ __forceinline__ unsigned xb_add(unsigned* p, unsigned v) { return __hip_atomic_fetch_add(p, v, __ATOMIC_RELAXED, __HIP_MEMORY_SCOPE_AGENT); }
__device__ __forceinline__ unsigned xb_xcc_id() { return (unsigned)__builtin_amdgcn_s_getreg((3 << 11) | 20) & 0xFu; }
#define XB_SPIN(cond, bar) do { unsigned _sp = 0; while (cond) { __builtin_amdgcn_s_sleep(1); \
    if ((++_sp & 255u) == 0u) { if (xb_ld(&(bar)[XB_TMO])) break; if (_sp > XB_SPIN_CAP) { atomicAdd(&(bar)[XB_TMO], 1u); break; } } } } while (0)

struct XcdBarrier { unsigned* bar; unsigned x; volatile LAS unsigned* st; unsigned G; };

__device__ __forceinline__ XcdBarrier xcd_barrier_post(unsigned* bar, volatile LAS unsigned* st, unsigned G) {
    XcdBarrier b; b.bar = bar; b.x = xb_xcc_id(); b.st = st; b.G = G;
    if (threadIdx.x == 0) (void)xb_add(&bar[XB_XCNT(b.x)], 1u);
    return b;
}
__device__ __forceinline__ void xcd_barrier_complete(unsigned* bar, unsigned x, unsigned& nloc, unsigned& nx, const unsigned G) {
    unsigned sum, cnt, mine, sp = 0u;
    for (;;) {
        sum = 0u; cnt = 0u; mine = 0u;
#pragma unroll
        for (unsigned j = 0; j < 16; ++j) { const unsigned c = xb_ld(&bar[XB_XCNT(j)]); sum += c; cnt += (c > 0u) ? 1u : 0u; mine = (j == x) ? c : mine; }
        if (sum == G) break;
        __builtin_amdgcn_s_sleep(1);
        if ((++sp & 255u) == 0u) { if (xb_ld(&bar[XB_TMO])) break; if (sp > XB_SPIN_CAP) { atomicAdd(&bar[XB_TMO], 1u); break; } }
    }
    nloc = mine > 0u ? mine : 1u; nx = cnt > 0u ? cnt : 1u;
}
__device__ __forceinline__ void xcd_barrier(const XcdBarrier& b) {
    asm volatile("s_waitcnt vmcnt(0)" ::: "memory");
    __syncthreads();
    if (threadIdx.x == 0) {
        unsigned* bar = b.bar;
        __builtin_amdgcn_s_waitcnt(0);
        unsigned nloc = b.st[0], nx = b.st[1];
        if (nloc == 0u) { xcd_barrier_complete(bar, b.x, nloc, nx, b.G); b.st[0] = nloc; b.st[1] = nx; }
        const unsigned old = xb_add(&bar[XB_XSUB(b.x)], 1u);
        const unsigned gen = old / nloc;
        if (old + 1u == (gen + 1u) * nloc) {
            __builtin_amdgcn_fence(__ATOMIC_RELEASE, "agent");
            asm volatile("s_waitcnt vmcnt(0)" ::: "memory");
            const unsigned og = xb_add(&bar[XB_TOP], 1u);
            const unsigned tg = og / nx;
            if (og + 1u == (tg + 1u) * nx) xb_add(&bar[XB_TOPGEN], 1u);
            else XB_SPIN(xb_ld(&bar[XB_TOPGEN]) == tg, bar);
            __builtin_amdgcn_fence(__ATOMIC_ACQUIRE, "agent");
            xb_add(&bar[XB_XGEN(b.x)], 1u);
            asm volatile("s_waitcnt vmcnt(0)" ::: "memory");
        } else {
            XB_SPIN(xb_ld(&bar[XB_XGEN(b.x)]) == gen, bar);
            __builtin_amdgcn_fence(__ATOMIC_ACQUIRE, "agent");
            asm volatile("s_waitcnt vmcnt(0)" ::: "memory");
        }
    }
    __syncthreads();
}

__device__ __forceinline__ float mod_at(const Frame& F, int b, int j) {
    const float* modp = (const float*)(F.ws + WS_MODP);
    float s = F.in[3][j];
#pragma unroll
    for (int kc = 0; kc < 16; ++kc) s += modp[(size_t)(kc * 8 + b) * NMOD + j];
    return s;
}

__device__ __forceinline__ void transpose_item(const float* W, int ldw, int k0, int n0, bf16_t* WT, int ldk, int drow0, LAS float* scr, int lane) {
#pragma unroll 8
    for (int i = 0; i < 32; ++i) { const int kk = 2 * i + (lane >> 5); scr[kk * 33 + (lane & 31)] = __builtin_nontemporal_load(W + (size_t)(k0 + kk) * ldw + n0 + (lane & 31)); }
    asm volatile("s_waitcnt lgkmcnt(0)" ::: "memory");
    const int c = lane & 7;
#pragma unroll
    for (int j = 0; j < 4; ++j) { const int n = (lane >> 3) + 8 * j; const LAS float* s = scr + (8 * c) * 33 + n;
        u32x4 o; o.x = pk2(s[0 * 33], s[1 * 33]); o.y = pk2(s[2 * 33], s[3 * 33]); o.z = pk2(s[4 * 33], s[5 * 33]); o.w = pk2(s[6 * 33], s[7 * 33]);
        *(u32x4*)(WT + (size_t)(drow0 + n) * ldk + k0 + 8 * c) = o; }
    asm volatile("s_waitcnt lgkmcnt(0)" ::: "memory");
}

template <int PART> __device__ __forceinline__ void phase_p0a(Frame& F) {
    const int gw = (PART ? F.vb : (int)blockIdx.x) * 8 + F.wave, NGW = (PART ? F.vg : (int)gridDim.x) * 8;
    LAS float* scr = (LAS float*)(F.lds + 32768 + F.wave * 8704);
    bf16_t* win_t = (bf16_t*)(F.ws + WS_WIN); bf16_t* wout_t = (bf16_t*)(F.ws + WS_WOUT); bf16_t* wgu_t = (bf16_t*)(F.ws + WS_WGU); bf16_t* wd_t = (bf16_t*)(F.ws + WS_WD);
    constexpr int I_IN = 16 * 80, I_OUT = 16 * 32, I_G = NE * 16 * 16, I_D = NE * 8 * 32, I_A = 16 * 8;
    if constexpr (PART == 1) {
        for (int it = gw; it < 2 * I_G + I_D; it += NGW) {
            int r = it;
            if (r < 2 * I_G) { const int up = r >= I_G; if (up) r -= I_G; const int e = r / 256, q = r % 256, kb = q / 16, nb = q % 16, n0 = 32 * nb;
                transpose_item(F.in[up ? 24 : 23] + (size_t)e * D * DE, DE, 64 * kb, n0, wgu_t + (size_t)e * D * D, D, (n0 / 128) * 256 + (n0 % 128) + (up ? 128 : 0), scr, F.lane); continue; } r -= 2 * I_G;
            { const int e = r / 256, q = r % 256, kb = q / 32, nb = q % 32; transpose_item(F.in[25] + (size_t)e * DE * D, D, 64 * kb, 32 * nb, wd_t + (size_t)e * D * DE, DE, 32 * nb, scr, F.lane); }
        }
    } else {
        const float* c = F.in[1]; const float* w_ada = F.in[2];
        LAS float* sc = (LAS float*)F.lds;
        for (int i = F.tid; i < NB * D; i += 512) sc[i] = siluf_(c[i]);
        __syncthreads();
        float* modp = (float*)(F.ws + WS_MODP);
        for (int it = gw; it < 96 * 16; it += NGW) {
            const int jc = it % 96, kc = it / 96, j = jc * 64 + F.lane;
            float a[8] = {0.f, 0.f, 0.f, 0.f, 0.f, 0.f, 0.f, 0.f};
#pragma unroll 8
            for (int kk = 0; kk < 64; ++kk) { const int k = kc * 64 + kk; const float w = __builtin_nontemporal_load(w_ada + (size_t)k * NMOD + j);
#pragma unroll
                for (int b = 0; b < 8; ++b) a[b] += sc[b * D + k] * w; }
#pragma unroll
            for (int b = 0; b < 8; ++b) modp[(size_t)(kc * 8 + b) * NMOD + j] = a[b];
        }
        for (int it = gw; it < I_IN + I_OUT + I_A; it += NGW) {
            int r = it;
            if (r < I_IN) { const int kb = r / 80, nb = r % 80; transpose_item(F.in[7], NIN, 64 * kb, 32 * nb, win_t, D, 32 * nb, scr, F.lane); continue; } r -= I_IN;
            if (r < I_OUT) { const int kb = r / 32, nb = r % 32; transpose_item(F.in[18], D, 64 * kb, 32 * nb, wout_t, D, 32 * nb, scr, F.lane); continue; } r -= I_OUT;
            {
                const int kb = r / 8, nb = r % 8, k = 64 * kb + F.lane; const float* wa2 = F.in[15];
                float g[16];
#pragma unroll
                for (int q = 0; q < 16; ++q) g[q] = F.in[7][(size_t)k * NIN + 2560 + q];
                for (int n = 0; n < 32; ++n) { float s = 0.f;
#pragma unroll
                    for (int q = 0; q < 16; ++q) s += g[q] * wa2[q * 256 + nb * 32 + n];
                    win_t[(size_t)(C_LA + nb * 32 + n) * D + k] = (bf16_t)f2bf(s); }
            }
        }
        {
            bf16_t* lw = (bf16_t*)(F.ws + WS_LRUW);
            for (int i = blockIdx.x * 512 + F.tid; i < 2 * LH * 64 * 64; i += gridDim.x * 512) { const int ii = i & 63, j = (i >> 6) & 63, hh = (i >> 12) & 7, w = i >> 15;
                lw[i] = (bf16_t)f2bf(F.in[w ? 12 : 10][(hh * 64 + ii) * 64 + j]); }
        }
        { bf16_t* wh = (bf16_t*)(F.ws + WS_WRT); bf16_t* wl = wh + 48 * D;
          for (int i = blockIdx.x * 512 + F.tid; i < 48 * D; i += gridDim.x * 512) { const int n = i / D, k = i % D; const float w = (n < 4) ? F.in[19][k * 4 + n] : (n < 36 ? F.in[21][k * 32 + (n - 4)] : 0.f);
              const unsigned h = f2bf(w); wh[i] = (bf16_t)h; wl[i] = (bf16_t)f2bf(w - bf2f((unsigned short)h)); } }
    }
}

__device__ __forceinline__ void phase_p0b(Frame& F) {
    float* mod = (float*)(F.ws + WS_MOD);
    for (int i = F.vb * 512 + F.tid; i < NB * NMOD; i += F.vg * 512) mod[i] = mod_at(F, i / NMOD, i % NMOD);
    LAS float* gm = (LAS float*)F.lds; LAS float* sh = gm + D;
    const float* x = F.in[0]; bf16_t* H = (bf16_t*)(F.ws + WS_H);
    for (int tile = (F.grp * NTG) + F.vb; tile < (F.grp * NTG) + NTG; tile += F.vg) {
        const int b = tile / 32;
        __syncthreads();
        for (int k = F.tid; k < D; k += 512) { gm[k] = F.in[4][k] * (1.0f + mod_at(F, b, D + k)); sh[k] = mod_at(F, b, k); }
        __syncthreads();
        f32x4 vn[2][4];
#pragma unroll
        for (int rr = 0; rr < 2; ++rr) { const f32x4* xr = (const f32x4*)(x + ((size_t)tile * 256 + F.wave * 2 + rr) * D) + F.lane;
#pragma unroll
            for (int j = 0; j < 4; ++j) vn[rr][j] = __builtin_nontemporal_load(xr + 64 * j); }
#pragma unroll 1
        for (int r = F.wave * 2; r < 256; r += 16) {
            f32x4 v[2][4]; float s[2] = {0.f, 0.f};
#pragma unroll
            for (int rr = 0; rr < 2; ++rr)
#pragma unroll
                for (int j = 0; j < 4; ++j) v[rr][j] = vn[rr][j];
            const int rn = (r + 16 < 256) ? r + 16 : r;
#pragma unroll
            for (int rr = 0; rr < 2; ++rr) { const f32x4* xr = (const f32x4*)(x + ((size_t)tile * 256 + rn + rr) * D) + F.lane;
#pragma unroll
                for (int j = 0; j < 4; ++j) vn[rr][j] = __builtin_nontemporal_load(xr + 64 * j); }
#pragma unroll
            for (int rr = 0; rr < 2; ++rr)
#pragma unroll
                for (int j = 0; j < 4; ++j) s[rr] += (v[rr][j].x * v[rr][j].x + v[rr][j].y * v[rr][j].y) + (v[rr][j].z * v[rr][j].z + v[rr][j].w * v[rr][j].w);
#pragma unroll
            for (int rr = 0; rr < 2; ++rr) {
                const float rstd = rsqrtf(wave_sum(s[rr]) * (1.0f / D) + EPS);
                u32x2* o = (u32x2*)(H + ((size_t)tile * 256 + r + rr) * D) + F.lane;
#pragma unroll
                for (int j = 0; j < 4; ++j) { const int k = 4 * F.lane + 256 * j; const f32x4 g = *(const LAS f32x4*)(gm + k), sv = *(const LAS f32x4*)(sh + k);
                    const f32x4 h = v[rr][j] * rstd * g + sv; u32x2 w; w.x = pk2(h.x, h.y); w.y = pk2(h.z, h.w); o[64 * j] = w; }
            }
        }
    }
}

__device__ __forceinline__ void phase_route(Frame& F) {
    const float* mod = (const float*)(F.ws + WS_MOD); const bf16_t* X1 = (const bf16_t*)(F.ws + WS_X1); bf16_t* H2 = (bf16_t*)(F.ws + WS_H);
    const bf16_t* WHL = (const bf16_t*)(F.ws + WS_WRT);
    int* tokE = (int*)(F.ws + WS_TOKE); float* tokW = (float*)(F.ws + WS_TOKW); int* bcnt = (int*)(F.ws + WS_BCNT);
    constexpr int WROW = 1040;
    LAS unsigned char* wl = F.lds;
    LAS float* gm = (LAS float*)(F.lds + 96 * WROW); LAS float* sh = gm + D; LAS int* cnt = (LAS int*)(sh + D); LAS float* lgw = (LAS float*)(cnt + 32) + F.wave * (16 * 49);
    const int lane = F.lane, fr = lane & 15, g = lane >> 4;
    for (int tile = (F.grp * NTG) + F.vb; tile < (F.grp * NTG) + NTG; tile += F.vg) {
        const int b = tile / 32;
        __syncthreads();
        for (int k = F.tid; k < D; k += 512) { gm[k] = F.in[5][k] * (1.0f + mod[(size_t)b * NMOD + 4 * D + k]); sh[k] = mod[(size_t)b * NMOD + 3 * D + k]; }
        if (F.tid < NE) cnt[F.tid] = 0;
        const size_t rowA = (size_t)tile * 256 + F.wave * 16 + fr;
        float rstd[2];
#pragma unroll
        for (int gq = 0; gq < 2; ++gq) { const f32x4 p = *(const f32x4*)((const float*)(F.ws + WS_SS) + (rowA + gq * 128) * 16 + 4 * g); float s = (p.x + p.y) + (p.z + p.w);
            s += __shfl_xor(s, 16); s += __shfl_xor(s, 32); rstd[gq] = rsqrtf(s * (1.0f / D) + EPS); }
        f32x4 acc[2][3];
#pragma unroll
        for (int gq = 0; gq < 2; ++gq)
#pragma unroll
            for (int n = 0; n < 3; ++n) acc[gq][n] = (f32x4){0.f, 0.f, 0.f, 0.f};
        const bf16_t* xp = X1 + rowA * D + 8 * g; bf16_t* hp = H2 + rowA * D + 8 * g;
#pragma unroll 1
        for (int half = 0; half < 2; ++half) {
            __syncthreads();
            for (int idx = F.tid; idx < 96 * 64; idx += 512) { const int r = idx >> 6, c16 = idx & 63;
                *(LAS u32x4*)(wl + r * WROW + 16 * c16) = *(const u32x4*)(WHL + (size_t)r * D + 512 * half + 8 * c16); }
            __syncthreads();
            u32x4 xn[2];
#pragma unroll
            for (int gq = 0; gq < 2; ++gq) xn[gq] = __builtin_nontemporal_load((const u32x4*)(xp + (size_t)gq * 128 * D + 512 * half));
#pragma unroll 1
            for (int qq = 0; qq < 16; ++qq) {
                const int q = 16 * half + qq, k0 = 32 * q + 8 * g;
                u32x4 xc[2] = {xn[0], xn[1]};
                const int qn = qq < 15 ? q + 1 : q;
#pragma unroll
                for (int gq = 0; gq < 2; ++gq) xn[gq] = __builtin_nontemporal_load((const u32x4*)(xp + (size_t)gq * 128 * D + 32 * qn));
                bf16x8 Wf[6];
#pragma unroll
                for (int n = 0; n < 3; ++n) { Wf[n] = *(const LAS bf16x8*)(wl + (16 * n + fr) * WROW + 64 * qq + 16 * g); Wf[3 + n] = *(const LAS bf16x8*)(wl + (48 + 16 * n + fr) * WROW + 64 * qq + 16 * g); }
                const f32x4 g0 = *(const LAS f32x4*)(gm + k0), g1 = *(const LAS f32x4*)(gm + k0 + 4), s0 = *(const LAS f32x4*)(sh + k0), s1 = *(const LAS f32x4*)(sh + k0 + 4);
#pragma unroll
                for (int gq = 0; gq < 2; ++gq) {
                    float f[8]; unpack8(xc[gq], f); const float rs = rstd[gq];
                    f[0] = f[0] * rs * g0.x + s0.x; f[1] = f[1] * rs * g0.y + s0.y; f[2] = f[2] * rs * g0.z + s0.z; f[3] = f[3] * rs * g0.w + s0.w;
                    f[4] = f[4] * rs * g1.x + s1.x; f[5] = f[5] * rs * g1.y + s1.y; f[6] = f[6] * rs * g1.z + s1.z; f[7] = f[7] * rs * g1.w + s1.w;
                    const u32x4 hi = {pk2(f[0], f[1]), pk2(f[2], f[3]), pk2(f[4], f[5]), pk2(f[6], f[7])};
                    *(u32x4*)(hp + (size_t)gq * 128 * D + 32 * q) = hi;
                    float hf[8]; unpack8(hi, hf);
                    const u32x4 lo = {pk2(f[0] - hf[0], f[1] - hf[1]), pk2(f[2] - hf[2], f[3] - hf[3]), pk2(f[4] - hf[4], f[5] - hf[5]), pk2(f[6] - hf[6], f[7] - hf[7])};
                    const bf16x8 Ah = __builtin_bit_cast(bf16x8, hi), Al = __builtin_bit_cast(bf16x8, lo);
#pragma unroll
                    for (int n = 0; n < 3; ++n) { acc[gq][n] = mfma16(Ah, Wf[n], acc[gq][n]); acc[gq][n] = mfma16(Al, Wf[n], acc[gq][n]); acc[gq][n] = mfma16(Ah, Wf[3 + n], acc[gq][n]); }
                }
            }
        }
#pragma unroll 1
        for (int gq = 0; gq < 2; ++gq) {
#pragma unroll
            for (int n = 0; n < 3; ++n)
#pragma unroll
                for (int q = 0; q < 4; ++q) lgw[(4 * g + q) * 49 + 16 * n + fr] = gq ? acc[1][n][q] : acc[0][n][q];
            asm volatile("s_waitcnt lgkmcnt(0)" ::: "memory");
            if (lane < 16) {
                const LAS float* lg = lgw + lane * 49; const size_t rr = (size_t)tile * 256 + gq * 128 + F.wave * 16 + lane;
                float cl[4];
#pragma unroll
                for (int j = 0; j < 4; ++j) cl[j] = lg[j] + F.in[20][j];
                int grp = 0; float cm = cl[0];
#pragma unroll
                for (int j = 1; j < 4; ++j) if (cl[j] > cm) { cm = cl[j]; grp = j; }
                float den = 0.f;
#pragma unroll
                for (int j = 0; j < 4; ++j) den += __expf(cl[j] - cm);
                const float pg = 1.0f / den;
                float fl[8];
#pragma unroll
                for (int j = 0; j < 8; ++j) fl[j] = lg[4 + 8 * grp + j] + F.in[22][grp * 8 + j];
                int i1 = 0; float m1 = fl[0];
#pragma unroll
                for (int j = 1; j < 8; ++j) if (fl[j] > m1) { m1 = fl[j]; i1 = j; }
                int i2 = -1; float m2 = -3.0e38f;
#pragma unroll
                for (int j = 0; j < 8; ++j) if (j != i1 && fl[j] > m2) { m2 = fl[j]; i2 = j; }
                const float e21 = __expf(m2 - m1), inv = 1.0f / (1.0f + e21);
                tokE[rr * 2] = grp * 8 + i1; tokE[rr * 2 + 1] = grp * 8 + i2;
                tokW[rr * 2] = pg * inv; tokW[rr * 2 + 1] = pg * e21 * inv;
                atomicAdd((int*)(cnt + grp * 8 + i1), 1); atomicAdd((int*)(cnt + grp * 8 + i2), 1);
            }
            asm volatile("s_waitcnt lgkmcnt(0)" ::: "memory");
        }
        __syncthreads();
        if (F.tid < NE) bcnt[tile * NE + F.tid] = cnt[F.tid];
    }
}

__device__ __forceinline__ void phase_slots(Frame& F) {
    const int* tokE = (const int*)(F.ws + WS_TOKE); const float* tokW = (const float*)(F.ws + WS_TOKW); const int* bcnt = (const int*)(F.ws + WS_BCNT);
    int* tokS = (int*)(F.ws + WS_TOKS); int* slotT = (int*)(F.ws + WS_SLOTT); float* slotW = (float*)(F.ws + WS_SLOTW);
    LAS int* tot = (LAS int*)F.lds; LAS int* base = tot + 32; LAS int* seg = base + 32; LAS int* el = seg + 64; LAS int* rk = el + 512;
    for (int tile = (F.grp * NTG) + F.vb; tile < (F.grp * NTG) + NTG; tile += F.vg) {
        __syncthreads();
        if (F.tid < 2 * NE) tot[F.tid] = 0;
        el[F.tid] = tokE[(size_t)tile * 512 + F.tid];
        __syncthreads();
        { const int e = F.tid & 31, part = F.tid >> 5; int t_ = 0, b_ = 0;
#pragma unroll
          for (int i = 0; i < NTG / 16; ++i) { const int q = (F.grp * NTG) + part + 16 * i; const int c = bcnt[q * NE + e]; t_ += c; if (q < tile) b_ += c; }
          atomicAdd((int*)(tot + e), t_); atomicAdd((int*)(base + e), b_); }
        __syncthreads();
        if (F.tid == 0) { int s = 0; for (int e = 0; e < NE; ++e) { seg[e] = s; s += (tot[e] + 255) & ~255; } seg[NE] = s; }
        {
            LAS int* wc_ = rk + 512;
            const int myE = el[F.tid]; int myR = 0;
            for (int e = 0; e < NE; ++e) { const unsigned long long mk = __ballot(myE == e); if (myE == e) myR = __popcll(mk & ((1ull << F.lane) - 1ull)); if (F.lane == 0) wc_[F.wave * 32 + e] = __popcll(mk); }
            __syncthreads();
            int add = 0; for (int w = 0; w < F.wave; ++w) add += wc_[w * 32 + myE];
            rk[F.tid] = myR + add;
        }
        __syncthreads();
        { const int e = el[F.tid], slot = (F.grp * SLOTS_G) + seg[e] + base[e] + rk[F.tid]; const size_t a = (size_t)tile * 512 + F.tid;
          slotT[slot] = (int)(a >> 1); slotW[slot] = tokW[a]; tokS[a] = slot; }
        if (tile - (F.grp * NTG) < NE) { const int e = tile - (F.grp * NTG); for (int s = seg[e] + tot[e] + F.tid; s < seg[e + 1]; s += 512) { slotT[(F.grp * SLOTS_G) + s] = 0; slotW[(F.grp * SLOTS_G) + s] = 0.f; } }
    }
}

__device__ __forceinline__ int moe_tiles(Frame& F, LAS int* tileE, LAS int* tileRow, LAS int* tmp) {
    const int* bcnt = (const int*)(F.ws + WS_BCNT);
    __syncthreads();
    if (F.tid < NE) tmp[F.tid] = 0;
    __syncthreads();
    { const int e = F.tid & 31, part = F.tid >> 5; int t_ = 0;
#pragma unroll
      for (int i = 0; i < NTG / 16; ++i) t_ += bcnt[((F.grp * NTG) + part + 16 * i) * NE + e];
      atomicAdd((int*)(tmp + e), t_); }
    __syncthreads();
    if (F.tid == 0) { int n = 0, s = 0; for (int e = 0; e < NE; ++e) { const int nt = (tmp[e] + 255) >> 8; for (int q = 0; q < nt; ++q) { tileE[n] = e; tileRow[n] = (F.grp * SLOTS_G) + s + q * 256; ++n; } s += nt * 256; } tmp[32] = n; }
    __syncthreads();
    return tmp[32];
}


__device__ __forceinline__ void phase_final(Frame& F) {
    const float* mod = (const float*)(F.ws + WS_MOD); const bf16_t* X1 = (const bf16_t*)(F.ws + WS_X1); const bf16_t* O = grp_o(F);
    const int* tokS = (const int*)(F.ws + WS_TOKS);
    LAS float* gtl = (LAS float*)F.lds; LAS float* gfl = gtl + D;
    for (int tile = (F.grp * NTG) + F.vb; tile < (F.grp * NTG) + NTG; tile += F.vg) {
        const int b = tile / 32;
        __syncthreads();
        for (int k = F.tid; k < D; k += 512) { gtl[k] = mod[(size_t)b * NMOD + 5 * D + k]; gfl[k] = F.in[6][k]; }
        __syncthreads();
        u32x2 xw[2][4], aw[2][4], cw[2][4];
#define FINAL_LOAD(rbase) do { _Pragma("unroll") for (int rr = 0; rr < 2; ++rr) { const size_t row = (size_t)tile * 256 + (rbase) + rr; const int s0 = tokS[row * 2], s1 = tokS[row * 2 + 1]; \
            const u32x2* xr = (const u32x2*)(X1 + row * D) + F.lane; const u32x2* o0 = (const u32x2*)(O + (size_t)s0 * D) + F.lane; const u32x2* o1 = (const u32x2*)(O + (size_t)s1 * D) + F.lane; \
            _Pragma("unroll") for (int j = 0; j < 4; ++j) { xw[rr][j] = __builtin_nontemporal_load(xr + 64 * j); aw[rr][j] = __builtin_nontemporal_load(o0 + 64 * j); cw[rr][j] = __builtin_nontemporal_load(o1 + 64 * j); } } } while (0)
        FINAL_LOAD(F.wave * 2);
#pragma unroll 1
        for (int r = F.wave * 2; r < 256; r += 16) {
            f32x4 v[2][4]; float s[2] = {0.f, 0.f};
#pragma unroll
            for (int rr = 0; rr < 2; ++rr)
#pragma unroll
                for (int j = 0; j < 4; ++j) { const u32x2 w = xw[rr][j], a = aw[rr][j], c = cw[rr][j]; const f32x4 g = *(const LAS f32x4*)(gtl + 4 * F.lane + 256 * j);
                    v[rr][j] = (f32x4){bflo(w.x) + g.x * (bflo(a.x) + bflo(c.x)), bfhi(w.x) + g.y * (bfhi(a.x) + bfhi(c.x)), bflo(w.y) + g.z * (bflo(a.y) + bflo(c.y)), bfhi(w.y) + g.w * (bfhi(a.y) + bfhi(c.y))};
                    s[rr] += (v[rr][j].x * v[rr][j].x + v[rr][j].y * v[rr][j].y) + (v[rr][j].z * v[rr][j].z + v[rr][j].w * v[rr][j].w); }
            const int rn = (r + 16 < 256) ? r + 16 : r;
            FINAL_LOAD(rn);
#pragma unroll
            for (int rr = 0; rr < 2; ++rr) {
                const float rstd = rsqrtf(wave_sum(s[rr]) * (1.0f / D) + EPS);
                f32x4* op = (f32x4*)(F.out + ((size_t)tile * 256 + r + rr) * D) + F.lane;
#pragma unroll
                for (int j = 0; j < 4; ++j) { const f32x4 g = *(const LAS f32x4*)(gfl + 4 * F.lane + 256 * j); __builtin_nontemporal_store(v[rr][j] * rstd * g, op + 64 * j); }
            }
        }
#undef FINAL_LOAD
    }
}

constexpr int TS136 = 136, TS144 = 144;
typedef unsigned short u16x4 __attribute__((ext_vector_type(4)));

__device__ __forceinline__ bf16x8 mk8(u32x2 lo, u32x2 hi) { u32x4 w = {lo.x, lo.y, hi.x, hi.y}; return __builtin_bit_cast(bf16x8, w); }
#define TR_ISSUE(dst, addr, off) asm volatile("ds_read_b64_tr_b16 %0, %1 offset:%2" : "=v"(dst) : "v"(addr), "i"(off) : "memory")
#define TR_WAIT4(a, b, c, d) asm volatile("s_waitcnt lgkmcnt(0)" : "+v"(a), "+v"(b), "+v"(c), "+v"(d) :: "memory")

__device__ __forceinline__ void chunk_cumsum(const u32x4 (&la8)[8], float (&bq)[8][8], float (&bl)[8], int lane) {
    float run[8];
#pragma unroll
    for (int j = 0; j < 8; ++j) run[j] = 0.f;
#pragma unroll
    for (int i = 0; i < 8; ++i) {
        const float f[8] = {bflo(la8[i].x), bfhi(la8[i].x), bflo(la8[i].y), bfhi(la8[i].y), bflo(la8[i].z), bfhi(la8[i].z), bflo(la8[i].w), bfhi(la8[i].w)};
#pragma unroll
        for (int j = 0; j < 8; ++j) { run[j] += f[j]; bq[i][j] = run[j]; }
    }
#pragma unroll
    for (int j = 0; j < 8; ++j) {
        float incl = run[j];
#pragma unroll
        for (int off = 8; off < 64; off <<= 1) { const float v = __shfl_up(incl, off); if (lane >= off) incl += v; }
        const float excl = incl - run[j];
        bl[j] = __shfl(incl, 56 + (lane & 7));
#pragma unroll
        for (int i = 0; i < 8; ++i) bq[i][j] += excl;
    }
}

__device__ __forceinline__ void gla_kv_task(Frame& F, LAS unsigned char* kt, LAS unsigned char* vt, int b, int n, int h, int eh) {
    const bf16_t* P = (const bf16_t*)(F.ws + WS_PROJ); bf16_t* KVT = grp_kvt(F); float* DEC = (float*)(F.ws + WS_DEC);
    const int lane = F.lane, r = lane >> 3, c = lane & 7, fr = lane & 15, g = lane >> 4;
    const size_t t0 = (size_t)b * SEQ + (size_t)n * 64; const int chi = (b * 128 + n) * 4 + h;
    u32x4 la8[8], k8[8];
    {
        u32x4 v8[8];
#pragma unroll
        for (int i = 0; i < 8; ++i) { const bf16_t* row = P + (t0 + 8 * r + i) * NPROJ; la8[i] = *(const u32x4*)(row + C_LA + 64 * h + 8 * c); k8[i] = *(const u32x4*)(row + C_K + 64 * h + 8 * c); v8[i] = *(const u32x4*)(row + C_V + 128 * h + 64 * eh + 8 * c); }
#pragma unroll
        for (int i = 0; i < 8; ++i) { LAS u32x2* d = (LAS u32x2*)(vt + (8 * r + i) * TS136 + 16 * c); d[0] = (u32x2){v8[i].x, v8[i].y}; d[1] = (u32x2){v8[i].z, v8[i].w}; }
    }
    float bq[8][8], bl[8];
    chunk_cumsum(la8, bq, bl, lane);
#pragma unroll
    for (int i = 0; i < 8; ++i) { float kf[8]; unpack8(k8[i], kf);
#pragma unroll
        for (int j = 0; j < 8; ++j) kf[j] *= __expf(bl[j] - bq[i][j]);
        LAS u32x2* d = (LAS u32x2*)(kt + (8 * r + i) * TS136 + 16 * c); d[0] = (u32x2){pk2(kf[0], kf[1]), pk2(kf[2], kf[3])}; d[1] = (u32x2){pk2(kf[4], kf[5]), pk2(kf[6], kf[7])}; }
    if (eh == 0 && r == 7) { float* dp = DEC + (size_t)chi * 64 + 8 * c;
#pragma unroll
        for (int j = 0; j < 8; ++j) dp[j] = __expf(bl[j]); }
    asm volatile("s_waitcnt lgkmcnt(0)" ::: "memory");
    f32x4 acc[4][4];
#pragma unroll
    for (int m = 0; m < 4; ++m)
#pragma unroll
        for (int nn = 0; nn < 4; ++nn) acc[m][nn] = (f32x4){0.f, 0.f, 0.f, 0.f};
    const int q4 = fr >> 2, p4 = fr & 3;
    const unsigned abase = (unsigned)(size_t)vt + (unsigned)((8 * g + q4) * TS136 + 8 * p4), bbase = (unsigned)(size_t)kt + (unsigned)((8 * g + q4) * TS136 + 8 * p4);
#pragma unroll
    for (int ks = 0; ks < 2; ++ks) {
        u32x2 alo[4], ahi[4], blo[4], bhi[4];
#pragma unroll
        for (int m = 0; m < 4; ++m) { TR_ISSUE(alo[m], abase, ks * 32 * TS136 + m * 32); TR_ISSUE(ahi[m], abase, ks * 32 * TS136 + 4 * TS136 + m * 32); }
#pragma unroll
        for (int nn = 0; nn < 4; ++nn) { TR_ISSUE(blo[nn], bbase, ks * 32 * TS136 + nn * 32); TR_ISSUE(bhi[nn], bbase, ks * 32 * TS136 + 4 * TS136 + nn * 32); }
        TR_WAIT4(alo[0], alo[1], alo[2], alo[3]); TR_WAIT4(ahi[0], ahi[1], ahi[2], ahi[3]); TR_WAIT4(blo[0], blo[1], blo[2], blo[3]); TR_WAIT4(bhi[0], bhi[1], bhi[2], bhi[3]);
#pragma unroll
        for (int m = 0; m < 4; ++m)
#pragma unroll
            for (int nn = 0; nn < 4; ++nn) acc[m][nn] = mfma16(mk8(alo[m], ahi[m]), mk8(blo[nn], bhi[nn]), acc[m][nn]);
    }
    bf16_t* out = KVT + (size_t)chi * 8192;
#pragma unroll
    for (int m = 0; m < 4; ++m)
#pragma unroll
        for (int nn = 0; nn < 4; ++nn)
#pragma unroll
            for (int q = 0; q < 4; ++q) out[(64 * eh + 16 * m + 4 * g + q) * 64 + 16 * nn + fr] = (bf16_t)f2bf(acc[m][nn][q]);
}

template <bool FINAL>
__device__ __forceinline__ void lru_tile(Frame& F, LAS float* cw, LAS unsigned char* axl, LAS unsigned char* ot, int tile, int h) {
    const bf16_t* P = (const bf16_t*)(F.ws + WS_PROJ); float* LSUM = (float*)(F.ws + WS_LSUM); bf16_t* MIX = (bf16_t*)(F.ws + WS_H);
    const bf16_t* LW = (const bf16_t*)(F.ws + WS_LRUW); u32x4* STASH = (u32x4*)(F.ws + WS_X1) + ((size_t)(tile * LH + h) * 64) * 64;
    const int lane = F.lane, fr = lane & 15, g = lane >> 4;
    const int b = tile / 32, c256 = tile % 32;
    float lc_[4], carry[4], PM[4];
#pragma unroll
    for (int n = 0; n < 4; ++n) { const float nl = -F.in[14][64 * h + 16 * n + fr]; lc_[n] = -8.0f * 1.4426950408889634f * (fmaxf(nl, 0.f) + log1pf(__expf(-fabsf(nl)))); carry[n] = 0.f; PM[n] = 1.f; }
    const size_t tbase = (size_t)tile * 256;
    if constexpr (!FINAL) {
#pragma unroll
        for (int k = 0; k < 4; ++k) cw[k * 64 + lane] = F.in[8][k * DL + 64 * h + lane];
        cw[256 + lane] = F.in[9][64 * h + lane];
        float br_[4], bi_[4];
        bf16x8 Br[4][2], Bi[4][2];
#pragma unroll
        for (int n = 0; n < 4; ++n) {
            const int ch = 64 * h + 16 * n + fr;
#pragma unroll
            for (int ks = 0; ks < 2; ++ks) {
                Br[n][ks] = *(const bf16x8*)(LW + ((size_t)(0 * 8 + h) * 64 + 16 * n + fr) * 64 + 32 * ks + 8 * g);
                Bi[n][ks] = *(const bf16x8*)(LW + ((size_t)(1 * 8 + h) * 64 + 16 * n + fr) * 64 + 32 * ks + 8 * g);
            }
            br_[n] = F.in[11][ch]; bi_[n] = F.in[13][ch];
        }
        asm volatile("s_waitcnt lgkmcnt(0)" ::: "memory");
#pragma unroll 1
        for (int sc = 0; sc < 4; ++sc) {
#pragma unroll 2
            for (int m = 0; m < 4; ++m) {
                const size_t t = tbase + sc * 64 + m * 16 + fr; const int pos = (int)(t % SEQ);
#pragma unroll
                for (int ks = 0; ks < 2; ++ks) {
                    const int c0 = 32 * ks + 8 * g;
                    float xc[8];
                    { const LAS f32x4* bp = (const LAS f32x4*)(cw + 256 + c0); const f32x4 b0 = bp[0], b1 = bp[1]; xc[0] = b0.x; xc[1] = b0.y; xc[2] = b0.z; xc[3] = b0.w; xc[4] = b1.x; xc[5] = b1.y; xc[6] = b1.z; xc[7] = b1.w; }
#pragma unroll
                    for (int k = 0; k < 4; ++k) {
                        u32x4 w = {0u, 0u, 0u, 0u};
                        if (pos - 3 + k >= 0) w = __builtin_nontemporal_load((const u32x4*)(P + (t - 3 + k) * NPROJ + C_LX + 64 * h + c0));
                        float xf[8]; unpack8(w, xf);
                        const LAS f32x4* wp = (const LAS f32x4*)(cw + k * 64 + c0); const f32x4 w0 = wp[0], w1 = wp[1];
                        xc[0] += w0.x * xf[0]; xc[1] += w0.y * xf[1]; xc[2] += w0.z * xf[2]; xc[3] += w0.w * xf[3]; xc[4] += w1.x * xf[4]; xc[5] += w1.y * xf[5]; xc[6] += w1.z * xf[6]; xc[7] += w1.w * xf[7];
                    }
                    *(LAS u32x4*)(axl + ((m * 2 + ks) * 64 + lane) * 16) = (u32x4){pk2(xc[0], xc[1]), pk2(xc[2], xc[3]), pk2(xc[4], xc[5]), pk2(xc[6], xc[7])};
                }
            }
            asm volatile("s_waitcnt lgkmcnt(0)" ::: "memory");
#pragma unroll 1
            for (int m = 0; m < 4; ++m) {
                bf16x8 A[2];
#pragma unroll
                for (int ks = 0; ks < 2; ++ks) A[ks] = *(const LAS bf16x8*)(axl + ((m * 2 + ks) * 64 + lane) * 16);
#pragma unroll
                for (int n = 0; n < 4; ++n) {
                    bf16x8 Id[2];
#pragma unroll
                    for (int ks = 0; ks < 2; ++ks) { bf16x8 id;
#pragma unroll
                        for (int j = 0; j < 8; ++j) id[j] = (32 * ks + 8 * g + j == 16 * n + fr) ? (short)0x3f80 : (short)0;
                        Id[ks] = id; }
                    f32x4 ar = {0.f, 0.f, 0.f, 0.f}, ai = ar, ax = ar;
#pragma unroll
                    for (int ks = 0; ks < 2; ++ks) { ar = mfma16(A[ks], Br[n][ks], ar); ai = mfma16(A[ks], Bi[n][ks], ai); ax = mfma16(A[ks], Id[ks], ax); }
                    u32x4 st; float a_[4], u_[4];
#pragma unroll
                    for (int q = 0; q < 4; ++q) {
                        const float rr = sigmoidf_(ar[q] + br_[n]), ii = sigmoidf_(ai[q] + bi_[n]);
                        const float a0 = __builtin_amdgcn_exp2f(rr * lc_[n]);
                        const float u0 = __builtin_amdgcn_sqrtf(fmaf(-a0, a0, 1.0f)) * ii * ax[q];
                        const unsigned w = pk2(rr, u0); st[q] = w;
                        a_[q] = __builtin_amdgcn_exp2f(bflo(w) * lc_[n]); u_[q] = bfhi(w);
                    }
                    STASH[((sc * 4 + m) * 4 + n) * 64 + lane] = st;
                    float Pq = a_[0] * a_[1] * a_[2] * a_[3];
                    float Hq = ((u_[0] * a_[1] + u_[1]) * a_[2] + u_[2]) * a_[3] + u_[3];
#pragma unroll
                    for (int off = 16; off < 64; off <<= 1) { const float Pp = __shfl_up(Pq, off), Hp = __shfl_up(Hq, off); if (lane >= off) { Hq = Hq + Pq * Hp; Pq = Pq * Pp; } }
                    const float Pl = __shfl(Pq, 48 + fr), Hl = __shfl(Hq, 48 + fr);
                    carry[n] = Hl + Pl * carry[n]; PM[n] *= Pl;
                }
            }
        }
        if (g == 0) {
#pragma unroll
            for (int n = 0; n < 4; ++n) *(f32x2*)(LSUM + ((size_t)tile * DL + 64 * h + 16 * n + fr) * 2) = (f32x2){PM[n], carry[n]};
        }
    } else {
#pragma unroll
        for (int n = 0; n < 4; ++n) {
            f32x2 sv[8];
#pragma unroll
            for (int i = 0; i < 8; ++i) { const int cp = 8 * g + i; sv[i] = (f32x2){1.f, 0.f}; if (cp < c256) sv[i] = *(const f32x2*)(LSUM + ((size_t)(b * 32 + cp) * DL + 64 * h + 16 * n + fr) * 2); }
            float Pg = 1.f, Hg = 0.f;
#pragma unroll
            for (int i = 0; i < 8; ++i) { Hg = sv[i].y + sv[i].x * Hg; Pg *= sv[i].x; }
            float cy = 0.f;
#pragma unroll
            for (int gg = 0; gg < 4; ++gg) { const float Ps = __shfl(Pg, 16 * gg + fr), Hs = __shfl(Hg, 16 * gg + fr); cy = Hs + Ps * cy; }
            carry[n] = cy;
        }
#pragma unroll 1
        for (int sc = 0; sc < 4; ++sc) {
#pragma unroll 2
            for (int m = 0; m < 4; ++m) {
                u32x4 st[4];
#pragma unroll
                for (int n = 0; n < 4; ++n) st[n] = __builtin_nontemporal_load(STASH + ((sc * 4 + m) * 4 + n) * 64 + lane);
#pragma unroll
                for (int n = 0; n < 4; ++n) {
                    float a_[4], u_[4];
#pragma unroll
                    for (int q = 0; q < 4; ++q) { a_[q] = __builtin_amdgcn_exp2f(bflo(st[n][q]) * lc_[n]); u_[q] = bfhi(st[n][q]); }
                    float Pq = a_[0] * a_[1] * a_[2] * a_[3];
                    float Hq = ((u_[0] * a_[1] + u_[1]) * a_[2] + u_[2]) * a_[3] + u_[3];
#pragma unroll
                    for (int off = 16; off < 64; off <<= 1) { const float Pp = __shfl_up(Pq, off), Hp = __shfl_up(Hq, off); if (lane >= off) { Hq = Hq + Pq * Hp; Pq = Pq * Pp; } }
                    float Pe = __shfl_up(Pq, 16), He = __shfl_up(Hq, 16); if (lane < 16) { Pe = 1.f; He = 0.f; }
                    float hh = He + Pe * carry[n];
#pragma unroll
                    for (int q = 0; q < 4; ++q) { hh = a_[q] * hh + u_[q]; *(LAS unsigned short*)(ot + (16 * m + 4 * g + q) * TS136 + (16 * n + fr) * 2) = (unsigned short)f2bf(hh); }
                    const float Pl = __shfl(Pq, 48 + fr), Hl = __shfl(Hq, 48 + fr);
                    carry[n] = Hl + Pl * carry[n];
                }
            }
            asm volatile("s_waitcnt lgkmcnt(0)" ::: "memory");
#pragma unroll
            for (int i = 0; i < 8; ++i) { const int row = 8 * i + (lane >> 3), cc = lane & 7; const LAS u32x2* s = (const LAS u32x2*)(ot + row * TS136 + 16 * cc); const u32x2 lo = s[0], hi = s[1];
                const size_t t = tbase + sc * 64 + row;
                float hf[8], yf[8]; unpack8((u32x4){lo.x, lo.y, hi.x, hi.y}, hf); unpack8(__builtin_nontemporal_load((const u32x4*)(P + t * NPROJ + C_LY + 64 * h + 8 * cc)), yf);
#pragma unroll
                for (int j = 0; j < 8; ++j) hf[j] *= gelu_tanh(yf[j]);
                *(u32x4*)(MIX + t * D + 64 * h + 8 * cc) = (u32x4){pk2(hf[0], hf[1]), pk2(hf[2], hf[3]), pk2(hf[4], hf[5]), pk2(hf[6], hf[7])}; }
            asm volatile("s_waitcnt lgkmcnt(0)" ::: "memory");
        }
    }
}

__device__ __forceinline__ void phase_mix_a(Frame& F) {
    LAS unsigned char* wb = F.lds + F.wave * (2 * 64 * TS136);
    for (int tile = (F.grp * NTG) + F.vb; tile < (F.grp * NTG) + NTG; tile += F.vg) lru_tile<false>(F, (LAS float*)wb, wb + 1280, nullptr, tile, F.wave);
    asm volatile("s_waitcnt lgkmcnt(0)" ::: "memory");
    for (int it = 4 * (F.grp * NTG) + F.vb; it < 4 * ((F.grp * NTG) + NTG); it += F.vg) gla_kv_task(F, wb, wb + 64 * TS136, it / 128, it % 128, F.wave >> 1, F.wave & 1);
}

__device__ __forceinline__ void phase_mix_b(Frame& F) {
    const bf16_t* KVT = grp_kvt(F); const float* DEC = (const float*)(F.ws + WS_DEC); bf16_t* ST = grp_st(F);
    for (int gid = F.vb * 512 + F.tid; gid < (NB / NGRP) * GH * 4096; gid += F.vg * 512) {
        const int bh = gid >> 12, rem = gid & 4095, b = F.grp * (NB / NGRP) + (bh >> 2), h = bh & 3;
        f32x2 S = {0.f, 0.f};
        for (int n0 = 0; n0 < 128; n0 += 16) {
            unsigned kv[16]; f32x2 dc[16];
#pragma unroll
            for (int q = 0; q < 16; ++q) { const size_t chi = (size_t)(b * 128 + n0 + q) * 4 + h; kv[q] = __builtin_nontemporal_load((const unsigned*)(KVT + chi * 8192 + rem * 2)); dc[q] = *(const f32x2*)(DEC + chi * 64 + (rem & 31) * 2); }
#pragma unroll
            for (int q = 0; q < 16; ++q) { const size_t chi = (size_t)(b * 128 + n0 + q) * 4 + h; *(unsigned*)(ST + chi * 8192 + rem * 2) = pk2(S.x, S.y); S = dc[q] * S + (f32x2){bflo(kv[q]), bfhi(kv[q])}; }
        }
    }
}

__device__ __forceinline__ void phase_mix_c(Frame& F) {
    const bf16_t* P = (const bf16_t*)(F.ws + WS_PROJ); const bf16_t* ST = grp_st(F); bf16_t* MIX = (bf16_t*)(F.ws + WS_H);
    const int lane = F.lane, r = lane >> 3, c = lane & 7, fr = lane & 15, g = lane >> 4, h = F.wave >> 1, eh = F.wave & 1;
    constexpr int HEAD_LDS = 2 * 64 * TS144 + 2 * 64 * TS136;
    LAS unsigned char* qt = F.lds + h * HEAD_LDS; LAS unsigned char* kdt = qt + 64 * TS144; LAS unsigned char* vt = kdt + 64 * TS144 + eh * 64 * TS136;
    LAS float* ssx = (LAS float*)(F.lds + 4 * HEAD_LDS);
    for (int tile = (F.grp * NTG) + F.vb; tile < (F.grp * NTG) + NTG; tile += F.vg)
        lru_tile<true>(F, (LAS float*)(F.lds + F.wave * 18176 + 8704), F.lds + F.wave * 18176 + 8704 + 1280, F.lds + F.wave * 18176, tile, F.wave);
    __syncthreads();
    for (int it = 4 * (F.grp * NTG) + F.vb; it < 4 * ((F.grp * NTG) + NTG); it += F.vg) {
        {
            const int b = it / 128, n = it % 128; const size_t t0 = (size_t)b * SEQ + (size_t)n * 64; const int chi = (b * 128 + n) * 4 + h;
            bf16x8 As[4][2]; u32x2 gw[4][4];
            {
                u32x4 la8[8], x8[8];
                {
                    u32x4 v8[8];
#pragma unroll
                    for (int i = 0; i < 8; ++i) { const bf16_t* row = P + (t0 + 8 * r + i) * NPROJ; la8[i] = __builtin_nontemporal_load((const u32x4*)(row + C_LA + 64 * h + 8 * c)); x8[i] = __builtin_nontemporal_load((const u32x4*)(row + (eh ? C_Q : C_K) + 64 * h + 8 * c)); v8[i] = __builtin_nontemporal_load((const u32x4*)(row + C_V + 128 * h + 64 * eh + 8 * c)); }
#pragma unroll
                    for (int m = 0; m < 4; ++m)
#pragma unroll
                        for (int ks = 0; ks < 2; ++ks) As[m][ks] = __builtin_nontemporal_load((const bf16x8*)(ST + (size_t)chi * 8192 + (size_t)(64 * eh + 16 * m + fr) * 64 + 32 * ks + 8 * g));
#pragma unroll
                    for (int nn = 0; nn < 4; ++nn)
#pragma unroll
                        for (int m = 0; m < 4; ++m) gw[nn][m] = __builtin_nontemporal_load((const u32x2*)(P + (t0 + 16 * nn + fr) * NPROJ + C_G + 128 * h + 64 * eh + 16 * m + 4 * g));
#pragma unroll
                    for (int i = 0; i < 8; ++i) { LAS u32x2* d = (LAS u32x2*)(vt + (8 * r + i) * TS136 + 16 * c); d[0] = (u32x2){v8[i].x, v8[i].y}; d[1] = (u32x2){v8[i].z, v8[i].w}; }
                }
                float bq[8][8], bl[8];
                chunk_cumsum(la8, bq, bl, lane);
                LAS unsigned char* dst = eh ? qt : kdt;
#pragma unroll
                for (int i = 0; i < 8; ++i) { float xf[8]; unpack8(x8[i], xf);
#pragma unroll
                    for (int j = 0; j < 8; ++j) xf[j] *= eh ? 0.125f * __expf(bq[i][j]) : __expf(-bq[i][j]);
                    *(LAS u32x4*)(dst + (8 * r + i) * TS144 + 16 * c) = (u32x4){pk2(xf[0], xf[1]), pk2(xf[2], xf[3]), pk2(xf[4], xf[5]), pk2(xf[6], xf[7])}; }
            }
            __syncthreads();
            bf16x8 Bq[4][2], Bp[4][2];
#pragma unroll
            for (int nn = 0; nn < 4; ++nn)
#pragma unroll
                for (int ks = 0; ks < 2; ++ks) Bq[nn][ks] = *(const LAS bf16x8*)(qt + (16 * nn + fr) * TS144 + 64 * ks + 16 * g);
            {
                f32x4 Pm[4][4];
#pragma unroll
                for (int mp = 0; mp < 4; ++mp) {
                    bf16x8 Ak[2];
#pragma unroll
                    for (int ks = 0; ks < 2; ++ks) Ak[ks] = *(const LAS bf16x8*)(kdt + (16 * mp + fr) * TS144 + 64 * ks + 16 * g);
#pragma unroll
                    for (int nn = 0; nn < 4; ++nn) { f32x4 p = {0.f, 0.f, 0.f, 0.f};
#pragma unroll
                        for (int ks = 0; ks < 2; ++ks) p = mfma16(Ak[ks], Bq[nn][ks], p);
#pragma unroll
                        for (int q = 0; q < 4; ++q) if (16 * nn + fr < 16 * mp + 4 * g + q) p[q] = 0.f;
                        Pm[mp][nn] = p; }
                }
#pragma unroll
                for (int nn = 0; nn < 4; ++nn)
#pragma unroll
                    for (int i = 0; i < 2; ++i) { const f32x4 lo = Pm[2 * i][nn], hi = Pm[2 * i + 1][nn];
                        u32x4 w = {pk2(lo[0], lo[1]), pk2(lo[2], lo[3]), pk2(hi[0], hi[1]), pk2(hi[2], hi[3])}; Bp[nn][i] = __builtin_bit_cast(bf16x8, w); }
            }
            f32x4 acc[4][4];
#pragma unroll
            for (int m = 0; m < 4; ++m)
#pragma unroll
                for (int nn = 0; nn < 4; ++nn) acc[m][nn] = (f32x4){0.f, 0.f, 0.f, 0.f};
            const int q4 = fr >> 2, p4 = fr & 3;
            const unsigned abase = (unsigned)(size_t)vt + (unsigned)((4 * g + q4) * TS136 + 8 * p4);
#pragma unroll
            for (int i = 0; i < 2; ++i) {
                u32x2 alo[4], ahi[4];
#pragma unroll
                for (int m = 0; m < 4; ++m) { TR_ISSUE(alo[m], abase, i * 32 * TS136 + m * 32); TR_ISSUE(ahi[m], abase, i * 32 * TS136 + 16 * TS136 + m * 32); }
                TR_WAIT4(alo[0], alo[1], alo[2], alo[3]); TR_WAIT4(ahi[0], ahi[1], ahi[2], ahi[3]);
#pragma unroll
                for (int m = 0; m < 4; ++m)
#pragma unroll
                    for (int nn = 0; nn < 4; ++nn) acc[m][nn] = mfma16(mk8(alo[m], ahi[m]), Bp[nn][i], acc[m][nn]);
            }
#pragma unroll
            for (int m = 0; m < 4; ++m)
#pragma unroll
                for (int nn = 0; nn < 4; ++nn)
#pragma unroll
                    for (int ks = 0; ks < 2; ++ks) acc[m][nn] = mfma16(As[m][ks], Bq[nn][ks], acc[m][nn]);
            float ss[4];
#pragma unroll
            for (int nn = 0; nn < 4; ++nn) { float s = 0.f;
#pragma unroll
                for (int m = 0; m < 4; ++m) s += (acc[m][nn][0] * acc[m][nn][0] + acc[m][nn][1] * acc[m][nn][1]) + (acc[m][nn][2] * acc[m][nn][2] + acc[m][nn][3] * acc[m][nn][3]);
                s += __shfl_xor(s, 16); s += __shfl_xor(s, 32); ss[nn] = s;
                if (g == 0) ssx[F.wave * 64 + 16 * nn + fr] = s; }
            __syncthreads();
#pragma unroll
            for (int nn = 0; nn < 4; ++nn) {
                const float rstd = rsqrtf((ss[nn] + ssx[(F.wave ^ 1) * 64 + 16 * nn + fr]) * (1.0f / 128.0f) + EPS);
                const size_t t = t0 + 16 * nn + fr;
#pragma unroll
                for (int m = 0; m < 4; ++m) {
                    const int e0 = 128 * h + 64 * eh + 16 * m + 4 * g;
                    const u32x2 gv = gw[nn][m];
                    const f32x4 gn = *(const f32x4*)(F.in[17] + 64 * eh + 16 * m + 4 * g);
                    const float y0 = acc[m][nn][0] * rstd * gn.x * siluf_(bflo(gv.x)), y1 = acc[m][nn][1] * rstd * gn.y * siluf_(bfhi(gv.x));
                    const float y2 = acc[m][nn][2] * rstd * gn.z * siluf_(bflo(gv.y)), y3 = acc[m][nn][3] * rstd * gn.w * siluf_(bfhi(gv.y));
                    *(u32x2*)(MIX + t * D + DL + e0) = (u32x2){pk2(y0, y1), pk2(y2, y3)};
                }
            }
        }
    }
}


__global__ void __launch_bounds__(512, 2) fwd(Args args) {
    extern __shared__ __attribute__((aligned(16))) unsigned char lds_raw[];
    Frame F; F.lds = (LAS unsigned char*)lds_raw; F.tid = threadIdx.x; F.lane = F.tid & 63; F.wave = __builtin_amdgcn_readfirstlane(F.tid >> 6);
    F.in = args.in; F.ws = args.ws; F.out = args.out;
    const int bx = (int)blockIdx.x;
    F.grp = (NGRP == 2) ? ((bx >> 3) & 1) : 0; F.vg = (int)gridDim.x / NGRP; F.vb = (NGRP == 2) ? ((bx & 7) | ((bx >> 4) << 3)) : bx;
    volatile LAS unsigned* bst = (volatile LAS unsigned*)(F.lds + LDS_BYTES - 32);
    if (F.tid < 4) bst[F.tid] = 0u;
    __syncthreads();
#define BAR_FULL()  XcdBarrier{(unsigned*)(F.ws + WS_CTL) + 1024, xb_xcc_id(), (volatile LAS unsigned*)(F.lds + LDS_BYTES - 32), (unsigned)gridDim.x}
#define BAR_GROUP() XcdBarrier{(unsigned*)(F.ws + WS_CTL) + 1024 + 4096 * (1 + F.grp), xb_xcc_id(), (volatile LAS unsigned*)(F.lds + LDS_BYTES - 24), (unsigned)F.vg}
    (void)xcd_barrier_post((unsigned*)(F.ws + WS_CTL) + 1024, bst, gridDim.x);
    (void)xcd_barrier_post((unsigned*)(F.ws + WS_CTL) + 1024 + 4096 * (1 + F.grp), bst + 2, (unsigned)F.vg);

#define FRESH() do { int t_ = threadIdx.x; asm volatile("" : "+v"(t_)); F.tid = t_; F.lane = t_ & 63; } while (0)
    phase_p0a<0>(F);
    xcd_barrier(BAR_FULL());
    FRESH();
    if (F.grp == NGRP - 1) phase_p0a<1>(F);
    FRESH();
    phase_p0b(F);
    xcd_barrier(BAR_GROUP());
    if (F.grp == NGRP - 1 && F.tid == 0) __hip_atomic_fetch_add((unsigned*)(F.ws + WS_CTL) + 512, 1u, __ATOMIC_RELAXED, __HIP_MEMORY_SCOPE_AGENT);
    {
        DenseFast S{(const bf16_t*)(F.ws + WS_H), (const bf16_t*)(F.ws + WS_WIN), D, NTG, NPROJ / 256, F.vg, F.vb, (F.grp * NTG)};
        EpiProj E{(bf16_t*)(F.ws + WS_PROJ), F.in[16]};
        gemm_fast<EpiProj, DenseFast, false>(F.lds, S, E);
    }
    xcd_barrier(BAR_GROUP());
    FRESH();
    phase_mix_a(F);
    xcd_barrier(BAR_GROUP());
    FRESH();
    phase_mix_b(F);
    xcd_barrier(BAR_GROUP());
    FRESH();
    phase_mix_c(F);
    xcd_barrier(BAR_GROUP());
    {
        DenseFast S{(const bf16_t*)(F.ws + WS_H), (const bf16_t*)(F.ws + WS_WOUT), D, NTG, D / 256, F.vg, F.vb, (F.grp * NTG)};
        EpiX1 E{(bf16_t*)(F.ws + WS_X1), F.in[0], (const float*)(F.ws + WS_MOD), (float*)(F.ws + WS_SS)};
        gemm_fast<EpiX1, DenseFast, false>(F.lds, S, E);
    }
    xcd_barrier(BAR_GROUP());
    FRESH();
    phase_route(F);
    xcd_barrier(BAR_GROUP());
    FRESH();
    phase_slots(F);
    xcd_barrier(BAR_GROUP());
    {
        if (F.tid == 0) { unsigned* rdy = (unsigned*)(F.ws + WS_CTL) + 512; unsigned sp = 0;
            while (__hip_atomic_load(rdy, __ATOMIC_RELAXED, __HIP_MEMORY_SCOPE_AGENT) < (unsigned)F.vg) { __builtin_amdgcn_s_sleep(4); if (++sp > (1u << 22)) break; }
            __builtin_amdgcn_fence(__ATOMIC_ACQUIRE, "agent"); asm volatile("s_waitcnt vmcnt(0)" ::: "memory"); }
        __syncthreads();
    }
    {
        LAS unsigned* rowoff = (LAS unsigned*)(F.lds + 131072); LAS int* tileE = (LAS int*)(F.lds + 140800); LAS int* tileRow = tileE + 640; LAS int* tmp = tileRow + 640;
        const int nt = moe_tiles(F, tileE, tileRow, tmp);
        MoeFast S{(const bf16_t*)(F.ws + WS_H), (const bf16_t*)(F.ws + WS_WGU), D, (size_t)D * D, tileE, tileRow, rowoff, nt, F.vg, F.vb};
        const int* slot_tok = (const int*)(F.ws + WS_SLOTT);
        for (int i = 0; i < 9; ++i) { const int w = S.unit_id(i); if (w < 0) break; const int r0 = tileRow[w >> 2];
            if (F.tid < 256) rowoff[i * 256 + F.tid] = (unsigned)slot_tok[r0 + F.tid] * (unsigned)(D * 2); }
        __syncthreads();
        EpiSwiglu E{grp_hid(F)};
        gemm_fast<EpiSwiglu, MoeFast, true>(F.lds, S, E);
    }
    xcd_barrier(BAR_GROUP());
    {
        LAS int* tileE = (LAS int*)(F.lds + 140800); LAS int* tileRow = tileE + 640; LAS int* tmp = tileRow + 640;
        const int nt = moe_tiles(F, tileE, tileRow, tmp);
        MoeFast S{grp_hid(F), (const bf16_t*)(F.ws + WS_WD), DE, (size_t)D * DE, tileE, tileRow, nullptr, nt, F.vg, F.vb};
        EpiDown E{grp_o(F), (const float*)(F.ws + WS_SLOTW)};
        gemm_fast<EpiDown, MoeFast, false>(F.lds, S, E);
    }
    xcd_barrier(BAR_GROUP());
    FRESH();
    phase_final(F);
}

extern "C" void kernel_launch(void* const* d_in, const int* in_sizes, int n_in, void* d_out, int out_size, void* d_ws, size_t ws_size, hipStream_t stream) {
    static int grid = 0;
    if (grid == 0) {
        if (n_in != 26 || in_sizes[0] != T * D || out_size != T * D || ws_size < WS_END) { fprintf(stderr, "kernel_launch: unexpected shapes (n_in %d, in0 %d, out %d, ws %zu)\n", n_in, n_in > 0 ? in_sizes[0] : -1, out_size, ws_size); grid = -1; return; }
        int dev = 0, cus = 0;
        if (hipGetDevice(&dev) != hipSuccess || hipDeviceGetAttribute(&cus, hipDeviceAttributeMultiprocessorCount, dev) != hipSuccess) { grid = -1; return; }
        if (hipFuncSetAttribute((const void*)fwd, hipFuncAttributeMaxDynamicSharedMemorySize, LDS_BYTES) != hipSuccess) { fprintf(stderr, "kernel_launch: hipFuncSetAttribute failed\n"); grid = -1; return; }
        int per_cu = 0;
        if (hipOccupancyMaxActiveBlocksPerMultiprocessor(&per_cu, (const void*)fwd, 512, LDS_BYTES) != hipSuccess || per_cu < 1) { fprintf(stderr, "kernel_launch: occupancy query reports %d workgroups per CU\n", per_cu); }
        (void)hipGetLastError();
        grid = cus > 0 ? cus : 256;
        grid &= ~15;
        if (grid < 16) { grid = -1; return; }
    }
    if (grid < 0) return;
    (void)hipMemsetAsync((char*)d_ws + WS_CTL, 0, CTL_BYTES, stream);
    Args a{};
    for (int i = 0; i < 26; ++i) a.in[i] = (const float*)d_in[i];
    a.out = (float*)d_out; a.ws = (unsigned char*)d_ws;
    hipLaunchKernelGGL(fwd, dim3(grid), dim3(512), LDS_BYTES, stream, a);
}
```

```cpp
#include <hip/hip_runtime.h>
#include <cstdio>
#include <cstdint>

#define GAS __attribute__((address_space(1)))
#define LAS __attribute__((address_space(3)))
typedef unsigned short bf16_t;
typedef short bf16x8 __attribute__((ext_vector_type(8)));
typedef float f32x4 __attribute__((ext_vector_type(4)));
typedef float f32x2 __attribute__((ext_vector_type(2)));
typedef unsigned u32x4 __attribute__((ext_vector_type(4)));
typedef unsigned u32x2 __attribute__((ext_vector_type(2)));

constexpr int NB = 8, SEQ = 8192, T = NB * SEQ, D = 1024;
constexpr int DL = 512, LH = 8, LHD = 64;
constexpr int GH = 4, GDK = 64, GDV = 128;
constexpr int NE = 32, DE = 512;
constexpr int NIN = 2576;
constexpr int NPROJ = 2816;
constexpr int C_LX = 0, C_LY = 512, C_Q = 1024, C_K = 1280, C_V = 1536, C_G = 2048, C_LA = 2560;
constexpr int NMOD = 6 * D;
constexpr int NGRP = 2;
constexpr int NTG = (T / 256) / NGRP;
constexpr int SLOTS_G = 2 * (T / NGRP) + NE * 256;
constexpr int MAXSLOT = NGRP * SLOTS_G;
constexpr float EPS = 1e-6f;

constexpr size_t MiB = 1u << 20;
constexpr size_t WS_CTL = 0, CTL_BYTES = 1 * MiB;
constexpr size_t WS_MODP = 1 * MiB;
constexpr size_t WS_MOD = 4 * MiB;
constexpr size_t WS_WIN = 5 * MiB;
constexpr size_t WS_WOUT = 11 * MiB;
constexpr size_t WS_WGU = 13 * MiB;
constexpr size_t WS_WD = 77 * MiB;
constexpr size_t WS_WRT = 109 * MiB;
constexpr size_t WS_LRUW = 109 * MiB + 256 * 1024;
constexpr size_t WS_LSUM = 110 * MiB;
constexpr size_t WS_TOKE = 111 * MiB;
constexpr size_t WS_TOKW = 112 * MiB;
constexpr size_t WS_TOKS = 113 * MiB;
constexpr size_t WS_BCNT = 114 * MiB;
constexpr size_t WS_SLOTT = 115 * MiB;
constexpr size_t WS_SLOTW = 116 * MiB;
constexpr size_t WS_SS = 118 * MiB;
constexpr size_t WS_H = 128 * MiB;
constexpr size_t WS_PROJ = 256 * MiB;
constexpr size_t WS_X1 = 608 * MiB;
constexpr size_t WS_GRP = 736 * MiB, GRP_BYTES = 72 * MiB;
constexpr size_t WS_DEC = 936 * MiB;
constexpr size_t PROJ_GRP_BYTES = (size_t)(T / NGRP) * NPROJ * 2;
constexpr size_t WS_END = 992 * MiB;
static_assert(WS_GRP + NGRP * GRP_BYTES <= WS_DEC && (size_t)SLOTS_G * DE * 2 <= GRP_BYTES && (size_t)SLOTS_G * D * 2 <= PROJ_GRP_BYTES, "workspace map");

constexpr int LDS_BYTES = 147456;

__device__ __forceinline__ unsigned f2bf(float f) { return (unsigned)__builtin_bit_cast(unsigned short, (__bf16)f); }
typedef __bf16 bf16v2 __attribute__((ext_vector_type(2)));
__device__ __forceinline__ unsigned pk2(float lo, float hi) { bf16v2 v = {(__bf16)lo, (__bf16)hi}; return __builtin_bit_cast(unsigned, v); }
__device__ __forceinline__ float bf2f(unsigned short b) { return __builtin_bit_cast(float, ((unsigned)b) << 16); }
__device__ __forceinline__ float bflo(unsigned w) { return __builtin_bit_cast(float, w << 16); }
__device__ __forceinline__ float bfhi(unsigned w) { return __builtin_bit_cast(float, w & 0xffff0000u); }
__device__ __forceinline__ float wave_sum(float v) {
#pragma unroll
    for (int o = 1; o < 64; o <<= 1) v += __shfl_xor(v, o);
    return v;
}
__device__ __forceinline__ float sigmoidf_(float x) { return __builtin_amdgcn_rcpf(1.0f + __builtin_amdgcn_exp2f(-1.4426950408889634f * x)); }
__device__ __forceinline__ float siluf_(float x) { return x * __builtin_amdgcn_rcpf(1.0f + __builtin_amdgcn_exp2f(-1.4426950408889634f * x)); }
__device__ __forceinline__ float gelu_tanh(float x) { const float u = -2.3022081985f * (x + 0.044715f * x * x * x); return x * __builtin_amdgcn_rcpf(1.0f + __builtin_amdgcn_exp2f(u)); }
__device__ __forceinline__ f32x4 mfma16(bf16x8 a, bf16x8 b, f32x4 c) { return __builtin_amdgcn_mfma_f32_16x16x32_bf16(a, b, c, 0, 0, 0); }
__device__ __forceinline__ void unpack8(const u32x4 w, float (&f)[8]) { f[0] = bflo(w.x); f[1] = bfhi(w.x); f[2] = bflo(w.y); f[3] = bfhi(w.y); f[4] = bflo(w.z); f[5] = bfhi(w.z); f[6] = bflo(w.w); f[7] = bfhi(w.w); }
__device__ __forceinline__ float logsig16(float z) { const float e = __builtin_amdgcn_exp2f(-1.4426950408889634f * fabsf(z)); return (fminf(z, 0.f) - 0.6931471805599453f * __builtin_amdgcn_logf(1.0f + e)) * 0.0625f; }
__host__ __device__ __forceinline__ int perm32(int rho) { const int n = rho >> 4, i = rho & 15; return 8 * (i >> 2) + 4 * n + (i & 3); }

struct Args { const float* in[26]; float* out; unsigned char* ws; };

struct Frame {
    LAS unsigned char* lds;
    int tid, lane, wave;
    const float* const* in;
    unsigned char* ws;
    float* out;
    int vb, vg, grp;
};

__device__ __forceinline__ bf16_t* grp_kvt(const Frame& F) { return (bf16_t*)(F.ws + WS_GRP + (size_t)F.grp * GRP_BYTES) - (size_t)F.grp * (NB / NGRP) * 128 * GH * 8192; }
__device__ __forceinline__ bf16_t* grp_st(const Frame& F) { return (bf16_t*)(F.ws + WS_GRP + (size_t)F.grp * GRP_BYTES + 32 * MiB) - (size_t)F.grp * (NB / NGRP) * 128 * GH * 8192; }
__device__ __forceinline__ bf16_t* grp_hid(const Frame& F) { return (bf16_t*)(F.ws + WS_GRP + (size_t)F.grp * GRP_BYTES) - (size_t)F.grp * SLOTS_G * DE; }
__device__ __forceinline__ bf16_t* grp_o(const Frame& F) { return (bf16_t*)(F.ws + WS_PROJ + (size_t)F.grp * PROJ_GRP_BYTES) - (size_t)F.grp * SLOTS_G * D; }

struct Unit { int pm, pn, e, row0; };

constexpr int BM = 256, BK = 64, HALF = 128, HTB = HALF * BK * 2, STAGE_BYTES = 8 * HTB;
__host__ __device__ __forceinline__ int lds_byte(int r, int c) { const int st = (r >> 4) * 2 + (c >> 5), rr = r & 15, cc = c & 31, ob = rr * 64 + cc * 2; return st * 1024 + (ob ^ (((ob >> 9) & 1) << 5)); }
__host__ __device__ __forceinline__ void stage_rc(int b, int& R, int& C) { const int st = b / 1024, sb = b % 1024, swz = sb ^ (((sb >> 9) & 1) << 5); R = (st >> 1) * 16 + swz / 64; C = (st & 1) * 32 + (swz % 64) / 2; }

template <class Epi, class Sched, bool GATHER>
__device__ __forceinline__ void gemm_fast(LAS unsigned char* lds, const Sched& S, const Epi& E) {
    int tid = threadIdx.x; asm volatile("" : "+v"(tid));
    const int wid = __builtin_amdgcn_readfirstlane(tid >> 6), lane = tid & 63, wr = wid >> 2, wc = wid & 3, fr = lane & 15, fq = lane >> 4;
    const int K = S.K, nt = K / BK;
    unsigned voffA[2], voffB[2]; int RA[2];
#pragma unroll
    for (int i = 0; i < 2; ++i) { int R, C; stage_rc(tid * 16 + i * 8192, R, C); const int Rb = Epi::PERM ? ((R & ~31) + perm32(R & 31)) : R;
        RA[i] = R; voffA[i] = GATHER ? (unsigned)(C * 2) : (unsigned)(R * K + C) * 2u; voffB[i] = (unsigned)(Rb * K + C) * 2u; }
    const size_t kstep = (size_t)(BK * 2);
    const size_t hstep = (size_t)HALF * K * 2;
    const unsigned ldsw = (unsigned)wid * 1024u;
    const int aoff = lds_byte(wr * 64 + fr, fq * 8), boff = lds_byte(wc * 32 + fr, fq * 8);
#define PG8_SA(b, h) (((b) * 2 + (h)) * HTB)
#define PG8_SB(b, h) ((4 + (b) * 2 + (h)) * HTB)
#define PG8_STAGE(bufoff, gbase, voff) do { _Pragma("unroll") for (int _i = 0; _i < 2; ++_i) \
        __builtin_amdgcn_global_load_lds((const unsigned*)((const char*)(gbase) + (voff)[_i]), (LAS unsigned*)(lds + (bufoff) + ldsw + _i * 8192), 16, 0, 0); } while (0)
#define PG8_STAGE_A(bufoff, gbase, h, ov) do { if constexpr (GATHER) { \
        __builtin_amdgcn_global_load_lds((const unsigned*)((const char*)(gbase) + (ov)[h][0]), (LAS unsigned*)(lds + (bufoff) + ldsw), 16, 0, 0); \
        __builtin_amdgcn_global_load_lds((const unsigned*)((const char*)(gbase) + (ov)[h][1]), (LAS unsigned*)(lds + (bufoff) + ldsw + 8192), 16, 0, 0); } \
      else { PG8_STAGE(bufoff, (gbase) + (h) * hstep, voffA); } } while (0)
#define PG8_LDA(dst, b, h) do { _Pragma("unroll") for (int m = 0; m < 4; ++m) _Pragma("unroll") for (int k = 0; k < 2; ++k) dst[m][k] = *(const LAS bf16x8*)(lds + PG8_SA(b, h) + aoff + m * 2048 + k * 1024); } while (0)
#define PG8_LDB(dst, b, h) do { _Pragma("unroll") for (int n = 0; n < 2; ++n) _Pragma("unroll") for (int k = 0; k < 2; ++k) dst[n][k] = *(const LAS bf16x8*)(lds + PG8_SB(b, h) + boff + n * 2048 + k * 1024); } while (0)
#define PG8_MMA(ai, bj, At, Bt) do { __builtin_amdgcn_s_setprio(1); _Pragma("unroll") for (int m = 0; m < 4; ++m) _Pragma("unroll") for (int n = 0; n < 2; ++n) _Pragma("unroll") for (int k = 0; k < 2; ++k) \
        acc[ai][bj][m][n] = __builtin_amdgcn_mfma_f32_16x16x32_bf16(Bt[n][k], At[m][k], acc[ai][bj][m][n], 0, 0, 0); __builtin_amdgcn_s_setprio(0); } while (0)
#define PG8_WAIT_V(n) asm volatile("s_waitcnt vmcnt(" #n ")" ::: "memory")
#define PG8_WAIT_L(n) asm volatile("s_waitcnt lgkmcnt(" #n ")" ::: "memory")
#define PG8_BAR __builtin_amdgcn_s_barrier()
#define PG8_SCHED __builtin_amdgcn_sched_barrier(0)
    Unit cur, nxt; int ui = 0;
    if (!S.next(0, cur)) return;
    f32x4 acc[2][2][4][2];
#pragma unroll
    for (int a = 0; a < 2; ++a)
#pragma unroll
        for (int b = 0; b < 2; ++b)
#pragma unroll
            for (int m = 0; m < 4; ++m)
#pragma unroll
                for (int n = 0; n < 2; ++n) acc[a][b][m][n] = (f32x4){0.f, 0.f, 0.f, 0.f};
    bf16x8 At[4][2], B0[2][2], B1[2][2];
    const char* cA = S.a_base(cur); const char* cB = S.b_base(cur);
    unsigned cv[2][2], nv[2][2];
    if constexpr (GATHER) {
#pragma unroll
        for (int h = 0; h < 2; ++h)
#pragma unroll
            for (int i = 0; i < 2; ++i) { cv[h][i] = S.a_rowoff(cur, h * HALF + RA[i]) + voffA[i]; nv[h][i] = cv[h][i]; }
    }
    PG8_STAGE(PG8_SB(0, 0), cB, voffB); PG8_STAGE(PG8_SB(0, 1), cB + hstep, voffB); PG8_STAGE_A(PG8_SA(0, 0), cA, 0, cv); PG8_STAGE_A(PG8_SA(0, 1), cA, 1, cv);
    if (wr == 1) PG8_BAR;
    PG8_WAIT_V(2); PG8_BAR;
    PG8_STAGE(PG8_SB(1, 0), cB + kstep, voffB); PG8_STAGE_A(PG8_SA(1, 0), cA + kstep, 0, cv); PG8_STAGE(PG8_SB(1, 1), cB + hstep + kstep, voffB);
    PG8_WAIT_V(6); PG8_BAR;
    for (;;) {
        const bool has_next = S.next(ui + 1, nxt);
        const char* nA = has_next ? S.a_base(nxt) : cA; const char* nB = has_next ? S.b_base(nxt) : cB;
        if constexpr (GATHER) {
            if (has_next) {
#pragma unroll
                for (int h = 0; h < 2; ++h)
#pragma unroll
                    for (int i = 0; i < 2; ++i) nv[h][i] = S.a_rowoff(nxt, h * HALF + RA[i]) + voffA[i];
            }
        }
        for (int t = 0; t < nt; t += 2) {
            const bool last = (t == nt - 2);
            const char* a1 = cA + (size_t)(t + 1) * kstep;
            const char* a2 = last ? nA : cA + (size_t)(t + 2) * kstep; const char* b2 = last ? nB : cB + (size_t)(t + 2) * kstep;
            const char* a3 = a2 + kstep; const char* b3 = b2 + kstep;
            unsigned lv[2][2];
            if constexpr (GATHER) {
#pragma unroll
                for (int h = 0; h < 2; ++h)
#pragma unroll
                    for (int i = 0; i < 2; ++i) lv[h][i] = last ? nv[h][i] : cv[h][i];
            }
            PG8_LDB(B0, 0, 0); PG8_LDB(B1, 0, 1); PG8_SCHED; PG8_LDA(At, 0, 0); PG8_STAGE_A(PG8_SA(1, 1), a1, 1, cv);
            PG8_WAIT_V(8); PG8_WAIT_L(0); PG8_BAR; PG8_MMA(0, 0, At, B0); PG8_MMA(0, 1, At, B1); PG8_BAR; PG8_SCHED;
            PG8_LDA(At, 0, 1); PG8_STAGE(PG8_SB(0, 0), b2, voffB); PG8_STAGE(PG8_SB(0, 1), b2 + hstep, voffB); PG8_STAGE_A(PG8_SA(0, 0), a2, 0, lv);
            PG8_WAIT_V(8); PG8_WAIT_L(0); PG8_BAR; PG8_MMA(1, 0, At, B0); PG8_MMA(1, 1, At, B1); PG8_BAR; PG8_SCHED;
            PG8_LDB(B0, 1, 0); PG8_LDB(B1, 1, 1); PG8_SCHED; PG8_LDA(At, 1, 0); PG8_STAGE_A(PG8_SA(0, 1), a2, 1, lv);
            PG8_WAIT_V(8); PG8_WAIT_L(0); PG8_BAR; PG8_MMA(0, 0, At, B0); PG8_MMA(0, 1, At, B1); PG8_BAR; PG8_SCHED;
            PG8_LDA(At, 1, 1); PG8_STAGE(PG8_SB(1, 0), b3, voffB); PG8_STAGE(PG8_SB(1, 1), b3 + hstep, voffB); PG8_STAGE_A(PG8_SA(1, 0), a3, 0, lv);
            PG8_WAIT_V(8); PG8_WAIT_L(0); PG8_BAR; PG8_MMA(1, 0, At, B0); PG8_MMA(1, 1, At, B1); PG8_BAR; PG8_SCHED;
        }
        if (wr == 0) PG8_BAR;
        E(acc, cur, wr, wc, fr, fq);
        if (!has_next) break;
#pragma unroll
        for (int a = 0; a < 2; ++a)
#pragma unroll
            for (int b = 0; b < 2; ++b)
#pragma unroll
                for (int m = 0; m < 4; ++m)
#pragma unroll
                    for (int n = 0; n < 2; ++n) acc[a][b][m][n] = (f32x4){0.f, 0.f, 0.f, 0.f};
        cur = nxt; cA = nA; cB = nB; ++ui;
        if constexpr (GATHER) {
#pragma unroll
            for (int h = 0; h < 2; ++h)
#pragma unroll
                for (int i = 0; i < 2; ++i) cv[h][i] = nv[h][i];
        }
        if (wr == 1) PG8_BAR;
    }
    PG8_WAIT_V(0);
    PG8_BAR;
#undef PG8_SA
#undef PG8_SB
#undef PG8_STAGE
#undef PG8_STAGE_A
#undef PG8_LDA
#undef PG8_LDB
#undef PG8_MMA
#undef PG8_WAIT_V
#undef PG8_WAIT_L
#undef PG8_BAR
#undef PG8_SCHED
}

struct DenseFast {
    const bf16_t* A; const bf16_t* Bt; int K, nM, nN, G, c, pm0;
    __device__ __forceinline__ bool next(int i, Unit& u) const {
        const int nwg = nM * nN; const long L = (long)i * G + c; if (L >= nwg) return false;
        int wgid = (int)L; { const int q = nwg / 8, r = nwg % 8, xcd = wgid % 8, off = wgid / 8; wgid = (xcd < r ? xcd * (q + 1) : r * (q + 1) + (xcd - r) * q) + off; }
        const int nig = 8 * nN, gid = wgid / nig, fm = gid * 8, gsz = (nM - fm) < 8 ? (nM - fm) : 8;
        u.pm = pm0 + fm + ((wgid % nig) % gsz); u.pn = (wgid % nig) / gsz; u.e = 0; u.row0 = u.pm * 256; return true;
    }
    __device__ __forceinline__ const char* a_base(const Unit& u) const { return (const char*)(A + (size_t)u.pm * 256 * K); }
    __device__ __forceinline__ const char* b_base(const Unit& u) const { return (const char*)(Bt + (size_t)u.pn * 256 * K); }
    __device__ __forceinline__ unsigned a_rowoff(const Unit&, int) const { return 0u; }
};
struct MoeFast {
    const bf16_t* A; const bf16_t* Bt; int K; size_t estride;
    LAS int* tileE; LAS int* tileRow; LAS unsigned* rowoff; int ntiles, G, c;
    __device__ __forceinline__ int unit_id(int i) const {
        const int nwg = ntiles * 4; const long L = (long)i * G + c; if (L >= nwg) return -1;
        const int q = nwg / 8, r = nwg % 8, xcd = (int)(L % 8), off = (int)(L / 8); return (xcd < r ? xcd * (q + 1) : r * (q + 1) + (xcd - r) * q) + off;
    }
    __device__ __forceinline__ bool next(int i, Unit& u) const { const int w = unit_id(i); if (w < 0) return false; u.pm = w >> 2; u.pn = w & 3; u.e = tileE[u.pm]; u.row0 = tileRow[u.pm]; u.e |= i << 8; return true; }
    __device__ __forceinline__ const char* a_base(const Unit& u) const { return rowoff ? (const char*)A : (const char*)(A + (size_t)u.row0 * K); }
    __device__ __forceinline__ const char* b_base(const Unit& u) const { return (const char*)(Bt + (size_t)(u.e & 255) * estride + (size_t)u.pn * 256 * K); }
    __device__ __forceinline__ unsigned a_rowoff(const Unit& u, int r) const { return rowoff[(u.e >> 8) * 256 + r]; }
};

__device__ __forceinline__ u32x4 pack8(f32x4 v0, f32x4 v1) { u32x4 w; w.x = pk2(v0[0], v0[1]); w.y = pk2(v0[2], v0[3]); w.z = pk2(v1[0], v1[1]); w.w = pk2(v1[2], v1[3]); return w; }

struct EpiProj {
    static constexpr bool PERM = true;
    bf16_t* P; const float* ba;
    __device__ __forceinline__ void operator()(const f32x4 (&acc)[2][2][4][2], const Unit& u, int wr, int wc, int fr, int fq) const {
        const int row0 = u.pm * 256 + wr * 64 + fr, col0 = u.pn * 256 + wc * 32 + 8 * fq;
#pragma unroll
        for (int ai = 0; ai < 2; ++ai)
#pragma unroll
            for (int m = 0; m < 4; ++m) { bf16_t* rowp = P + (size_t)(row0 + ai * 128 + m * 16) * NPROJ + col0;
#pragma unroll
                for (int bj = 0; bj < 2; ++bj) { f32x4 v0 = acc[ai][bj][m][0], v1 = acc[ai][bj][m][1];
                    if (u.pn == 10) { const float* bp = ba + (col0 + bj * 128 - C_LA);
#pragma unroll
                        for (int j = 0; j < 4; ++j) { float z = v0[j] + bp[j]; v0[j] = logsig16(z); z = v1[j] + bp[4 + j]; v1[j] = logsig16(z); } }
                    *(u32x4*)(rowp + bj * 128) = pack8(v0, v1); } }
    }
};
struct EpiX1 {
    static constexpr bool PERM = true;
    bf16_t* X1; const float* x; const float* mod; float* SS;
    __device__ __forceinline__ void operator()(const f32x4 (&acc)[2][2][4][2], const Unit& u, int wr, int wc, int fr, int fq) const {
        const int row0 = u.pm * 256 + wr * 64 + fr, col0 = u.pn * 256 + wc * 32 + 8 * fq;
        const float* gt = mod + (size_t)(u.pm / 32) * NMOD + 2 * D;
        f32x4 g0[2], g1[2];
#pragma unroll
        for (int bj = 0; bj < 2; ++bj) { g0[bj] = *(const f32x4*)(gt + col0 + bj * 128); g1[bj] = *(const f32x4*)(gt + col0 + bj * 128 + 4); }
#pragma unroll
        for (int ai = 0; ai < 2; ++ai)
#pragma unroll
            for (int m = 0; m < 4; ++m) { const int r = row0 + ai * 128 + m * 16; float s = 0.f;
#pragma unroll
                for (int bj = 0; bj < 2; ++bj) { const size_t o = (size_t)r * D + col0 + bj * 128;
                    const f32x4 x0 = __builtin_nontemporal_load((const f32x4*)(x + o)), x1 = __builtin_nontemporal_load((const f32x4*)(x + o + 4));
                    const u32x4 w = pack8(x0 + g0[bj] * acc[ai][bj][m][0], x1 + g1[bj] * acc[ai][bj][m][1]);
                    *(u32x4*)(X1 + o) = w;
                    float f[8]; unpack8(w, f);
#pragma unroll
                    for (int j = 0; j < 8; ++j) s += f[j] * f[j]; }
                s += __shfl_xor(s, 16); s += __shfl_xor(s, 32);
                if (fq == 0) SS[(size_t)r * 16 + u.pn * 4 + wc] = s; }
    }
};
struct EpiSwiglu {
    static constexpr bool PERM = true;
    bf16_t* HID;
    __device__ __forceinline__ void operator()(const f32x4 (&acc)[2][2][4][2], const Unit& u, int wr, int wc, int fr, int fq) const {
        const int row0 = u.row0 + wr * 64 + fr, col0 = u.pn * 128 + wc * 32 + 8 * fq;
#pragma unroll
        for (int ai = 0; ai < 2; ++ai)
#pragma unroll
            for (int m = 0; m < 4; ++m) { f32x4 h0, h1;
#pragma unroll
                for (int j = 0; j < 4; ++j) { h0[j] = siluf_(acc[ai][0][m][0][j]) * acc[ai][1][m][0][j]; h1[j] = siluf_(acc[ai][0][m][1][j]) * acc[ai][1][m][1][j]; }
                *(u32x4*)(HID + (size_t)(row0 + ai * 128 + m * 16) * DE + col0) = pack8(h0, h1); }
    }
};
struct EpiDown {
    static constexpr bool PERM = true;
    bf16_t* O; const float* slot_w;
    __device__ __forceinline__ void operator()(const f32x4 (&acc)[2][2][4][2], const Unit& u, int wr, int wc, int fr, int fq) const {
        const int row0 = u.row0 + wr * 64 + fr, col0 = u.pn * 256 + wc * 32 + 8 * fq;
#pragma unroll
        for (int ai = 0; ai < 2; ++ai)
#pragma unroll
            for (int m = 0; m < 4; ++m) { const int r = row0 + ai * 128 + m * 16; const float w = slot_w[r];
#pragma unroll
                for (int bj = 0; bj < 2; ++bj) *(u32x4*)(O + (size_t)r * D + col0 + bj * 128) = pack8(acc[ai][bj][m][0] * w, acc[ai][bj][m][1] * w); }
    }
};


#define XB_TMO      128
#define XB_XCNT(j)  (256  + 64 * (j))
#define XB_XSUB(j)  (1280 + 64 * (j))
#define XB_XGEN(j)  (2304 + 64 * (j))
#define XB_TOP      3328
#define XB_TOPGEN   3392
#define XCD_BAR_WORDS 3456
#define XB_SPIN_CAP (1u << 18)

__device__ __forceinline__ unsigned xb_ld(unsigned* p)              { return __hip_atomic_load(p, __ATOMIC_RELAXED, __HIP_MEMORY_SCOPE_AGENT); }
__device__ __forceinline__ unsigned xb_add(unsigned* p, unsigned v) { return __hip_atomic_fetch_add(p, v, __ATOMIC_RELAXED, __HIP_MEMORY_SCOPE_AGENT); }
__device__ __forceinline__ unsigned xb_xcc_id() { return (unsigned)__builtin_amdgcn_s_getreg((3 << 11) | 20) & 0xFu; }
#define XB_SPIN(cond, bar) do { unsigned _sp = 0; while (cond) { __builtin_amdgcn_s_sleep(1); \
    if ((++_sp & 255u) == 0u) { if (xb_ld(&(bar)[XB_TMO])) break; if (_sp > XB_SPIN_CAP) { atomicAdd(&(bar)[XB_TMO], 1u); break; } } } } while (0)

struct XcdBarrier { unsigned* bar; unsigned x; volatile LAS unsigned* st; unsigned G; };

__device__ __forceinline__ XcdBarrier xcd_barrier_post(unsigned* bar, volatile LAS unsigned* st, unsigned G) {
    XcdBarrier b; b.bar = bar; b.x = xb_xcc_id(); b.st = st; b.G = G;
    if (threadIdx.x == 0) (void)xb_add(&bar[XB_XCNT(b.x)], 1u);
    return b;
}
__device__ __forceinline__ void xcd_barrier_complete(unsigned* bar, unsigned x, unsigned& nloc, unsigned& nx, const unsigned G) {
    unsigned sum, cnt, mine, sp = 0u;
    for (;;) {
        sum = 0u; cnt = 0u; mine = 0u;
#pragma unroll
        for (unsigned j = 0; j < 16; ++j) { const unsigned c = xb_ld(&bar[XB_XCNT(j)]); sum += c; cnt += (c > 0u) ? 1u : 0u; mine = (j == x) ? c : mine; }
        if (sum == G) break;
        __builtin_amdgcn_s_sleep(1);
        if ((++sp & 255u) == 0u) { if (xb_ld(&bar[XB_TMO])) break; if (sp > XB_SPIN_CAP) { atomicAdd(&bar[XB_TMO], 1u); break; } }
    }
    nloc = mine > 0u ? mine : 1u; nx = cnt > 0u ? cnt : 1u;
}
__device__ __forceinline__ void xcd_barrier(const XcdBarrier& b) {
    asm volatile("s_waitcnt vmcnt(0)" ::: "memory");
    __syncthreads();
    if (threadIdx.x == 0) {
        unsigned* bar = b.bar;
        __builtin_amdgcn_s_waitcnt(0);
        unsigned nloc = b.st[0], nx = b.st[1];
        if (nloc == 0u) { xcd_barrier_complete(bar, b.x, nloc, nx, b.G); b.st[0] = nloc; b.st[1] = nx; }
        const unsigned old = xb_add(&bar[XB_XSUB(b.x)], 1u);
        const unsigned gen = old / nloc;
        if (old + 1u == (gen + 1u) * nloc) {
            __builtin_amdgcn_fence(__ATOMIC_RELEASE, "agent");
            asm volatile("s_waitcnt vmcnt(0)" ::: "memory");
            const unsigned og = xb_add(&bar[XB_TOP], 1u);
            const unsigned tg = og / nx;
            if (og + 1u == (tg + 1u) * nx) xb_add(&bar[XB_TOPGEN], 1u);
            else XB_SPIN(xb_ld(&bar[XB_TOPGEN]) == tg, bar);
            __builtin_amdgcn_fence(__ATOMIC_ACQUIRE, "agent");
            xb_add(&bar[XB_XGEN(b.x)], 1u);
            asm volatile("s_waitcnt vmcnt(0)" ::: "memory");
        } else {
            XB_SPIN(xb_ld(&bar[XB_XGEN(b.x)]) == gen, bar);
            __builtin_amdgcn_fence(__ATOMIC_ACQUIRE, "agent");
            asm volatile("s_waitcnt vmcnt(0)" ::: "memory");
        }
    }
    __syncthreads();
}

__device__ __forceinline__ float mod_at(const Frame& F, int b, int j) {
    const float* modp = (const float*)(F.ws + WS_MODP);
    float s = F.in[3][j];
#pragma unroll
    for (int kc = 0; kc < 16; ++kc) s += modp[(size_t)(kc * 8 + b) * NMOD + j];
    return s;
}

template <bool NT_STORE = false>
__device__ __forceinline__ void transpose_item(const float* W, int ldw, int k0, int n0, bf16_t* WT, int ldk, int drow0, LAS float* scr, int lane) {
#pragma unroll 8
    for (int i = 0; i < 32; ++i) { const int kk = 2 * i + (lane >> 5); scr[kk * 33 + (lane & 31)] = __builtin_nontemporal_load(W + (size_t)(k0 + kk) * ldw + n0 + (lane & 31)); }
    asm volatile("s_waitcnt lgkmcnt(0)" ::: "memory");
    const int c = lane & 7;
#pragma unroll
    for (int j = 0; j < 4; ++j) { const int n = (lane >> 3) + 8 * j; const LAS float* s = scr + (8 * c) * 33 + n;
        u32x4 o; o.x = pk2(s[0 * 33], s[1 * 33]); o.y = pk2(s[2 * 33], s[3 * 33]); o.z = pk2(s[4 * 33], s[5 * 33]); o.w = pk2(s[6 * 33], s[7 * 33]);
        if (NT_STORE) __builtin_nontemporal_store(o, (u32x4*)(WT + (size_t)(drow0 + n) * ldk + k0 + 8 * c)); else *(u32x4*)(WT + (size_t)(drow0 + n) * ldk + k0 + 8 * c) = o; }
    asm volatile("s_waitcnt lgkmcnt(0)" ::: "memory");
}

template <int PART> __device__ __forceinline__ void phase_p0a(Frame& F) {
    const int gw = (PART ? F.vb : (int)blockIdx.x) * 8 + F.wave, NGW = (PART ? F.vg : (int)gridDim.x) * 8;
    LAS float* scr = (LAS float*)(F.lds + 32768 + F.wave * 8704);
    bf16_t* win_t = (bf16_t*)(F.ws + WS_WIN); bf16_t* wout_t = (bf16_t*)(F.ws + WS_WOUT); bf16_t* wgu_t = (bf16_t*)(F.ws + WS_WGU); bf16_t* wd_t = (bf16_t*)(F.ws + WS_WD);
    constexpr int I_IN = 16 * 80, I_OUT = 16 * 32, I_G = NE * 16 * 16, I_D = NE * 8 * 32, I_A = 16 * 8;
    if constexpr (PART == 1) {
        for (int it = gw; it < 2 * I_G + I_D; it += NGW) {
            int r = it;
            if (r < 2 * I_G) { const int up = r >= I_G; if (up) r -= I_G; const int e = r / 256, q = r % 256, kb = q / 16, nb = q % 16, n0 = 32 * nb;
                transpose_item<true>(F.in[up ? 24 : 23] + (size_t)e * D * DE, DE, 64 * kb, n0, wgu_t + (size_t)e * D * D, D, (n0 / 128) * 256 + (n0 % 128) + (up ? 128 : 0), scr, F.lane); continue; } r -= 2 * I_G;
            { const int e = r / 256, q = r % 256, kb = q / 32, nb = q % 32; transpose_item<true>(F.in[25] + (size_t)e * DE * D, D, 64 * kb, 32 * nb, wd_t + (size_t)e * D * DE, DE, 32 * nb, scr, F.lane); }
        }
    } else {
        const float* c = F.in[1]; const float* w_ada = F.in[2];
        LAS float* sc = (LAS float*)F.lds;
        for (int i = F.tid; i < NB * D; i += 512) sc[i] = siluf_(c[i]);
        __syncthreads();
        float* modp = (float*)(F.ws + WS_MODP);
        for (int it = gw; it < 96 * 16; it += NGW) {
            const int jc = it % 96, kc = it / 96, j = jc * 64 + F.lane;
            float a[8] = {0.f, 0.f, 0.f, 0.f, 0.f, 0.f, 0.f, 0.f};
#pragma unroll 8
            for (int kk = 0; kk < 64; ++kk) { const int k = kc * 64 + kk; const float w = __builtin_nontemporal_load(w_ada + (size_t)k * NMOD + j);
#pragma unroll
                for (int b = 0; b < 8; ++b) a[b] += sc[b * D + k] * w; }
#pragma unroll
            for (int b = 0; b < 8; ++b) modp[(size_t)(kc * 8 + b) * NMOD + j] = a[b];
        }
        for (int it = gw; it < I_IN + I_OUT + I_A; it += NGW) {
            int r = it;
            if (r < I_IN) { const int kb = r / 80, nb = r % 80; transpose_item(F.in[7], NIN, 64 * kb, 32 * nb, win_t, D, 32 * nb, scr, F.lane); continue; } r -= I_IN;
            if (r < I_OUT) { const int kb = r / 32, nb = r % 32; transpose_item(F.in[18], D, 64 * kb, 32 * nb, wout_t, D, 32 * nb, scr, F.lane); continue; } r -= I_OUT;
            {
                const int kb = r / 8, nb = r % 8, k = 64 * kb + F.lane; const float* wa2 = F.in[15];
                float g[16];
#pragma unroll
                for (int q = 0; q < 16; ++q) g[q] = F.in[7][(size_t)k * NIN + 2560 + q];
                for (int n = 0; n < 32; ++n) { float s = 0.f;
#pragma unroll
                    for (int q = 0; q < 16; ++q) s += g[q] * wa2[q * 256 + nb * 32 + n];
                    win_t[(size_t)(C_LA + nb * 32 + n) * D + k] = (bf16_t)f2bf(s); }
            }
        }
        {
            bf16_t* lw = (bf16_t*)(F.ws + WS_LRUW);
            for (int i = blockIdx.x * 512 + F.tid; i < 2 * LH * 64 * 64; i += gridDim.x * 512) { const int ii = i & 63, j = (i >> 6) & 63, hh = (i >> 12) & 7, w = i >> 15;
                lw[i] = (bf16_t)f2bf(F.in[w ? 12 : 10][(hh * 64 + ii) * 64 + j]); }
        }
        { bf16_t* wh = (bf16_t*)(F.ws + WS_WRT); bf16_t* wl = wh + 48 * D;
          for (int i = blockIdx.x * 512 + F.tid; i < 48 * D; i += gridDim.x * 512) { const int n = i / D, k = i % D; const float w = (n < 4) ? F.in[19][k * 4 + n] : (n < 36 ? F.in[21][k * 32 + (n - 4)] : 0.f);
              const unsigned h = f2bf(w); wh[i] = (bf16_t)h; wl[i] = (bf16_t)f2bf(w - bf2f((unsigned short)h)); } }
    }
}

__device__ __forceinline__ void phase_p0b(Frame& F) {
    float* mod = (float*)(F.ws + WS_MOD);
    for (int i = F.vb * 512 + F.tid; i < NB * NMOD; i += F.vg * 512) mod[i] = mod_at(F, i / NMOD, i % NMOD);
    LAS float* gm = (LAS float*)F.lds; LAS float* sh = gm + D;
    const float* x = F.in[0]; bf16_t* H = (bf16_t*)(F.ws + WS_H);
    for (int tile = (F.grp * NTG) + F.vb; tile < (F.grp * NTG) + NTG; tile += F.vg) {
        const int b = tile / 32;
        __syncthreads();
        for (int k = F.tid; k < D; k += 512) { gm[k] = F.in[4][k] * (1.0f + mod_at(F, b, D + k)); sh[k] = mod_at(F, b, k); }
        __syncthreads();
        f32x4 vn[2][4];
#pragma unroll
        for (int rr = 0; rr < 2; ++rr) { const f32x4* xr = (const f32x4*)(x + ((size_t)tile * 256 + F.wave * 2 + rr) * D) + F.lane;
#pragma unroll
            for (int j = 0; j < 4; ++j) vn[rr][j] = __builtin_nontemporal_load(xr + 64 * j); }
#pragma unroll 1
        for (int r = F.wave * 2; r < 256; r += 16) {
            f32x4 v[2][4]; float s[2] = {0.f, 0.f};
#pragma unroll
            for (int rr = 0; rr < 2; ++rr)
#pragma unroll
                for (int j = 0; j < 4; ++j) v[rr][j] = vn[rr][j];
            const int rn = (r + 16 < 256) ? r + 16 : r;
#pragma unroll
            for (int rr = 0; rr < 2; ++rr) { const f32x4* xr = (const f32x4*)(x + ((size_t)tile * 256 + rn + rr) * D) + F.lane;
#pragma unroll
                for (int j = 0; j < 4; ++j) vn[rr][j] = __builtin_nontemporal_load(xr + 64 * j); }
#pragma unroll
            for (int rr = 0; rr < 2; ++rr)
#pragma unroll
                for (int j = 0; j < 4; ++j) s[rr] += (v[rr][j].x * v[rr][j].x + v[rr][j].y * v[rr][j].y) + (v[rr][j].z * v[rr][j].z + v[rr][j].w * v[rr][j].w);
#pragma unroll
            for (int rr = 0; rr < 2; ++rr) {
                const float rstd = rsqrtf(wave_sum(s[rr]) * (1.0f / D) + EPS);
                u32x2* o = (u32x2*)(H + ((size_t)tile * 256 + r + rr) * D) + F.lane;
#pragma unroll
                for (int j = 0; j < 4; ++j) { const int k = 4 * F.lane + 256 * j; const f32x4 g = *(const LAS f32x4*)(gm + k), sv = *(const LAS f32x4*)(sh + k);
                    const f32x4 h = v[rr][j] * rstd * g + sv; u32x2 w; w.x = pk2(h.x, h.y); w.y = pk2(h.z, h.w); o[64 * j] = w; }
            }
        }
    }
}

__device__ __forceinline__ void phase_route(Frame& F) {
    const float* mod = (const float*)(F.ws + WS_MOD); const bf16_t* X1 = (const bf16_t*)(F.ws + WS_X1); bf16_t* H2 = (bf16_t*)(F.ws + WS_H);
    const bf16_t* WHL = (const bf16_t*)(F.ws + WS_WRT);
    int* tokE = (int*)(F.ws + WS_TOKE); float* tokW = (float*)(F.ws + WS_TOKW); int* bcnt = (int*)(F.ws + WS_BCNT);
    constexpr int WROW = 1040;
    LAS unsigned char* wl = F.lds;
    LAS float* gm = (LAS float*)(F.lds + 96 * WROW); LAS float* sh = gm + D; LAS int* cnt = (LAS int*)(sh + D); LAS float* lgw = (LAS float*)(cnt + 32) + F.wave * (16 * 49);
    const int lane = F.lane, fr = lane & 15, g = lane >> 4;
    for (int tile = (F.grp * NTG) + F.vb; tile < (F.grp * NTG) + NTG; tile += F.vg) {
        const int b = tile / 32;
        __syncthreads();
        for (int k = F.tid; k < D; k += 512) { gm[k] = F.in[5][k] * (1.0f + mod[(size_t)b * NMOD + 4 * D + k]); sh[k] = mod[(size_t)b * NMOD + 3 * D + k]; }
        if (F.tid < NE) cnt[F.tid] = 0;
        const size_t rowA = (size_t)tile * 256 + F.wave * 16 + fr;
        float rstd[2];
#pragma unroll
        for (int gq = 0; gq < 2; ++gq) { const f32x4 p = *(const f32x4*)((const float*)(F.ws + WS_SS) + (rowA + gq * 128) * 16 + 4 * g); float s = (p.x + p.y) + (p.z + p.w);
            s += __shfl_xor(s, 16); s += __shfl_xor(s, 32); rstd[gq] = rsqrtf(s * (1.0f / D) + EPS); }
        f32x4 acc[2][3];
#pragma unroll
        for (int gq = 0; gq < 2; ++gq)
#pragma unroll
            for (int n = 0; n < 3; ++n) acc[gq][n] = (f32x4){0.f, 0.f, 0.f, 0.f};
        const bf16_t* xp = X1 + rowA * D + 8 * g; bf16_t* hp = H2 + rowA * D + 8 * g;
#pragma unroll 1
        for (int half = 0; half < 2; ++half) {
            __syncthreads();
            for (int idx = F.tid; idx < 96 * 64; idx += 512) { const int r = idx >> 6, c16 = idx & 63;
                *(LAS u32x4*)(wl + r * WROW + 16 * c16) = *(const u32x4*)(WHL + (size_t)r * D + 512 * half + 8 * c16); }
            __syncthreads();
            u32x4 xn[2];
#pragma unroll
            for (int gq = 0; gq < 2; ++gq) xn[gq] = __builtin_nontemporal_load((const u32x4*)(xp + (size_t)gq * 128 * D + 512 * half));
#pragma unroll 1
            for (int qq = 0; qq < 16; ++qq) {
                const int q = 16 * half + qq, k0 = 32 * q + 8 * g;
                u32x4 xc[2] = {xn[0], xn[1]};
                const int qn = qq < 15 ? q + 1 : q;
#pragma unroll
                for (int gq = 0; gq < 2; ++gq) xn[gq] = __builtin_nontemporal_load((const u32x4*)(xp + (size_t)gq * 128 * D + 32 * qn));
                bf16x8 Wf[6];
#pragma unroll
                for (int n = 0; n < 3; ++n) { Wf[n] = *(const LAS bf16x8*)(wl + (16 * n + fr) * WROW + 64 * qq + 16 * g); Wf[3 + n] = *(const LAS bf16x8*)(wl + (48 + 16 * n + fr) * WROW + 64 * qq + 16 * g); }
                const f32x4 g0 = *(const LAS f32x4*)(gm + k0), g1 = *(const LAS f32x4*)(gm + k0 + 4), s0 = *(const LAS f32x4*)(sh + k0), s1 = *(const LAS f32x4*)(sh + k0 + 4);
#pragma unroll
                for (int gq = 0; gq < 2; ++gq) {
                    float f[8]; unpack8(xc[gq], f); const float rs = rstd[gq];
                    f[0] = f[0] * rs * g0.x + s0.x; f[1] = f[1] * rs * g0.y + s0.y; f[2] = f[2] * rs * g0.z + s0.z; f[3] = f[3] * rs * g0.w + s0.w;
                    f[4] = f[4] * rs * g1.x + s1.x; f[5] = f[5] * rs * g1.y + s1.y; f[6] = f[6] * rs * g1.z + s1.z; f[7] = f[7] * rs * g1.w + s1.w;
                    const u32x4 hi = {pk2(f[0], f[1]), pk2(f[2], f[3]), pk2(f[4], f[5]), pk2(f[6], f[7])};
                    *(u32x4*)(hp + (size_t)gq * 128 * D + 32 * q) = hi;
                    float hf[8]; unpack8(hi, hf);
                    const u32x4 lo = {pk2(f[0] - hf[0], f[1] - hf[1]), pk2(f[2] - hf[2], f[3] - hf[3]), pk2(f[4] - hf[4], f[5] - hf[5]), pk2(f[6] - hf[6], f[7] - hf[7])};
                    const bf16x8 Ah = __builtin_bit_cast(bf16x8, hi), Al = __builtin_bit_cast(bf16x8, lo);
#pragma unroll
                    for (int n = 0; n < 3; ++n) { acc[gq][n] = mfma16(Ah, Wf[n], acc[gq][n]); acc[gq][n] = mfma16(Al, Wf[n], acc[gq][n]); acc[gq][n] = mfma16(Ah, Wf[3 + n], acc[gq][n]); }
                }
            }
        }
#pragma unroll 1
        for (int gq = 0; gq < 2; ++gq) {
#pragma unroll
            for (int n = 0; n < 3; ++n)
#pragma unroll
                for (int q = 0; q < 4; ++q) lgw[(4 * g + q) * 49 + 16 * n + fr] = gq ? acc[1][n][q] : acc[0][n][q];
            asm volatile("s_waitcnt lgkmcnt(0)" ::: "memory");
            if (lane < 16) {
                const LAS float* lg = lgw + lane * 49; const size_t rr = (size_t)tile * 256 + gq * 128 + F.wave * 16 + lane;
                float cl[4];
#pragma unroll
                for (int j = 0; j < 4; ++j) cl[j] = lg[j] + F.in[20][j];
                int grp = 0; float cm = cl[0];
#pragma unroll
                for (int j = 1; j < 4; ++j) if (cl[j] > cm) { cm = cl[j]; grp = j; }
                float den = 0.f;
#pragma unroll
                for (int j = 0; j < 4; ++j) den += __expf(cl[j] - cm);
                const float pg = 1.0f / den;
                float fl[8];
#pragma unroll
                for (int j = 0; j < 8; ++j) fl[j] = lg[4 + 8 * grp + j] + F.in[22][grp * 8 + j];
                int i1 = 0; float m1 = fl[0];
#pragma unroll
                for (int j = 1; j < 8; ++j) if (fl[j] > m1) { m1 = fl[j]; i1 = j; }
                int i2 = -1; float m2 = -3.0e38f;
#pragma unroll
                for (int j = 0; j < 8; ++j) if (j != i1 && fl[j] > m2) { m2 = fl[j]; i2 = j; }
                const float e21 = __expf(m2 - m1), inv = 1.0f / (1.0f + e21);
                tokE[rr * 2] = grp * 8 + i1; tokE[rr * 2 + 1] = grp * 8 + i2;
                tokW[rr * 2] = pg * inv; tokW[rr * 2 + 1] = pg * e21 * inv;
                atomicAdd((int*)(cnt + grp * 8 + i1), 1); atomicAdd((int*)(cnt + grp * 8 + i2), 1);
            }
            asm volatile("s_waitcnt lgkmcnt(0)" ::: "memory");
        }
        __syncthreads();
        if (F.tid < NE) bcnt[tile * NE + F.tid] = cnt[F.tid];
    }
}

__device__ __forceinline__ void phase_slots(Frame& F) {
    const int* tokE = (const int*)(F.ws + WS_TOKE); const float* tokW = (const float*)(F.ws + WS_TOKW); const int* bcnt = (const int*)(F.ws + WS_BCNT);
    int* tokS = (int*)(F.ws + WS_TOKS); int* slotT = (int*)(F.ws + WS_SLOTT); float* slotW = (float*)(F.ws + WS_SLOTW);
    LAS int* tot = (LAS int*)F.lds; LAS int* base = tot + 32; LAS int* seg = base + 32; LAS int* el = seg + 64; LAS int* rk = el + 512;
    for (int tile = (F.grp * NTG) + F.vb; tile < (F.grp * NTG) + NTG; tile += F.vg) {
        __syncthreads();
        if (F.tid < 2 * NE) tot[F.tid] = 0;
        el[F.tid] = tokE[(size_t)tile * 512 + F.tid];
        __syncthreads();
        { const int e = F.tid & 31, part = F.tid >> 5; int t_ = 0, b_ = 0;
#pragma unroll
          for (int i = 0; i < NTG / 16; ++i) { const int q = (F.grp * NTG) + part + 16 * i; const int c = bcnt[q * NE + e]; t_ += c; if (q < tile) b_ += c; }
          atomicAdd((int*)(tot + e), t_); atomicAdd((int*)(base + e), b_); }
        __syncthreads();
        if (F.tid == 0) { int s = 0; for (int e = 0; e < NE; ++e) { seg[e] = s; s += (tot[e] + 255) & ~255; } seg[NE] = s; }
        {
            LAS int* wc_ = rk + 512;
            const int myE = el[F.tid]; int myR = 0;
            for (int e = 0; e < NE; ++e) { const unsigned long long mk = __ballot(myE == e); if (myE == e) myR = __popcll(mk & ((1ull << F.lane) - 1ull)); if (F.lane == 0) wc_[F.wave * 32 + e] = __popcll(mk); }
            __syncthreads();
            int add = 0; for (int w = 0; w < F.wave; ++w) add += wc_[w * 32 + myE];
            rk[F.tid] = myR + add;
        }
        __syncthreads();
        { const int e = el[F.tid], slot = (F.grp * SLOTS_G) + seg[e] + base[e] + rk[F.tid]; const size_t a = (size_t)tile * 512 + F.tid;
          slotT[slot] = (int)(a >> 1); slotW[slot] = tokW[a]; tokS[a] = slot; }
        if (tile - (F.grp * NTG) < NE) { const int e = tile - (F.grp * NTG); for (int s = seg[e] + tot[e] + F.tid; s < seg[e + 1]; s += 512) { slotT[(F.grp * SLOTS_G) + s] = 0; slotW[(F.grp * SLOTS_G) + s] = 0.f; } }
    }
}

__device__ __forceinline__ int moe_tiles(Frame& F, LAS int* tileE, LAS int* tileRow, LAS int* tmp) {
    const int* bcnt = (const int*)(F.ws + WS_BCNT);
    __syncthreads();
    if (F.tid < NE) tmp[F.tid] = 0;
    __syncthreads();
    { const int e = F.tid & 31, part = F.tid >> 5; int t_ = 0;
#pragma unroll
      for (int i = 0; i < NTG / 16; ++i) t_ += bcnt[((F.grp * NTG) + part + 16 * i) * NE + e];
      atomicAdd((int*)(tmp + e), t_); }
    __syncthreads();
    if (F.tid == 0) { int n = 0, s = 0; for (int e = 0; e < NE; ++e) { const int nt = (tmp[e] + 255) >> 8; for (int q = 0; q < nt; ++q) { tileE[n] = e; tileRow[n] = (F.grp * SLOTS_G) + s + q * 256; ++n; } s += nt * 256; } tmp[32] = n; }
    __syncthreads();
    return tmp[32];
}


__device__ __forceinline__ void phase_final(Frame& F) {
    const float* mod = (const float*)(F.ws + WS_MOD); const bf16_t* X1 = (const bf16_t*)(F.ws + WS_X1); const bf16_t* O = grp_o(F);
    const int* tokS = (const int*)(F.ws + WS_TOKS);
    LAS float* gtl = (LAS float*)F.lds; LAS float* gfl = gtl + D;
    for (int tile = (F.grp * NTG) + F.vb; tile < (F.grp * NTG) + NTG; tile += F.vg) {
        const int b = tile / 32;
        __syncthreads();
        for (int k = F.tid; k < D; k += 512) { gtl[k] = mod[(size_t)b * NMOD + 5 * D + k]; gfl[k] = F.in[6][k]; }
        __syncthreads();
        u32x2 xw[2][4], aw[2][4], cw[2][4];
#define FINAL_LOAD(rbase) do { _Pragma("unroll") for (int rr = 0; rr < 2; ++rr) { const size_t row = (size_t)tile * 256 + (rbase) + rr; const int s0 = tokS[row * 2], s1 = tokS[row * 2 + 1]; \
            const u32x2* xr = (const u32x2*)(X1 + row * D) + F.lane; const u32x2* o0 = (const u32x2*)(O + (size_t)s0 * D) + F.lane; const u32x2* o1 = (const u32x2*)(O + (size_t)s1 * D) + F.lane; \
            _Pragma("unroll") for (int j = 0; j < 4; ++j) { xw[rr][j] = __builtin_nontemporal_load(xr + 64 * j); aw[rr][j] = __builtin_nontemporal_load(o0 + 64 * j); cw[rr][j] = __builtin_nontemporal_load(o1 + 64 * j); } } } while (0)
        FINAL_LOAD(F.wave * 2);
#pragma unroll 1
        for (int r = F.wave * 2; r < 256; r += 16) {
            f32x4 v[2][4]; float s[2] = {0.f, 0.f};
#pragma unroll
            for (int rr = 0; rr < 2; ++rr)
#pragma unroll
                for (int j = 0; j < 4; ++j) { const u32x2 w = xw[rr][j], a = aw[rr][j], c = cw[rr][j]; const f32x4 g = *(const LAS f32x4*)(gtl + 4 * F.lane + 256 * j);
                    v[rr][j] = (f32x4){bflo(w.x) + g.x * (bflo(a.x) + bflo(c.x)), bfhi(w.x) + g.y * (bfhi(a.x) + bfhi(c.x)), bflo(w.y) + g.z * (bflo(a.y) + bflo(c.y)), bfhi(w.y) + g.w * (bfhi(a.y) + bfhi(c.y))};
                    s[rr] += (v[rr][j].x * v[rr][j].x + v[rr][j].y * v[rr][j].y) + (v[rr][j].z * v[rr][j].z + v[rr][j].w * v[rr][j].w); }
            const int rn = (r + 16 < 256) ? r + 16 : r;
            FINAL_LOAD(rn);
#pragma unroll
            for (int rr = 0; rr < 2; ++rr) {
                const float rstd = rsqrtf(wave_sum(s[rr]) * (1.0f / D) + EPS);
                f32x4* op = (f32x4*)(F.out + ((size_t)tile * 256 + r + rr) * D) + F.lane;
#pragma unroll
                for (int j = 0; j < 4; ++j) { const f32x4 g = *(const LAS f32x4*)(gfl + 4 * F.lane + 256 * j); __builtin_nontemporal_store(v[rr][j] * rstd * g, op + 64 * j); }
            }
        }
#undef FINAL_LOAD
    }
}

constexpr int TS136 = 136, TS144 = 144;
typedef unsigned short u16x4 __attribute__((ext_vector_type(4)));

__device__ __forceinline__ bf16x8 mk8(u32x2 lo, u32x2 hi) { u32x4 w = {lo.x, lo.y, hi.x, hi.y}; return __builtin_bit_cast(bf16x8, w); }
#define TR_ISSUE(dst, addr, off) asm volatile("ds_read_b64_tr_b16 %0, %1 offset:%2" : "=v"(dst) : "v"(addr), "i"(off) : "memory")
#define TR_WAIT4(a, b, c, d) asm volatile("s_waitcnt lgkmcnt(0)" : "+v"(a), "+v"(b), "+v"(c), "+v"(d) :: "memory")

__device__ __forceinline__ void chunk_cumsum(const u32x4 (&la8)[8], float (&bq)[8][8], float (&bl)[8], int lane) {
    float run[8];
#pragma unroll
    for (int j = 0; j < 8; ++j) run[j] = 0.f;
#pragma unroll
    for (int i = 0; i < 8; ++i) {
        const float f[8] = {bflo(la8[i].x), bfhi(la8[i].x), bflo(la8[i].y), bfhi(la8[i].y), bflo(la8[i].z), bfhi(la8[i].z), bflo(la8[i].w), bfhi(la8[i].w)};
#pragma unroll
        for (int j = 0; j < 8; ++j) { run[j] += f[j]; bq[i][j] = run[j]; }
    }
#pragma unroll
    for (int j = 0; j < 8; ++j) {
        float incl = run[j];
#pragma unroll
        for (int off = 8; off < 64; off <<= 1) { const float v = __shfl_up(incl, off); if (lane >= off) incl += v; }
        const float excl = incl - run[j];
        bl[j] = __shfl(incl, 56 + (lane & 7));
#pragma unroll
        for (int i = 0; i < 8; ++i) bq[i][j] += excl;
    }
}

__device__ __forceinline__ void gla_kv_task(Frame& F, LAS unsigned char* kt, LAS unsigned char* vt, int b, int n, int h, int eh) {
    const bf16_t* P = (const bf16_t*)(F.ws + WS_PROJ); bf16_t* KVT = grp_kvt(F); float* DEC = (float*)(F.ws + WS_DEC);
    const int lane = F.lane, r = lane >> 3, c = lane & 7, fr = lane & 15, g = lane >> 4;
    const size_t t0 = (size_t)b * SEQ + (size_t)n * 64; const int chi = (b * 128 + n) * 4 + h;
    u32x4 la8[8], k8[8];
    {
        u32x4 v8[8];
#pragma unroll
        for (int i = 0; i < 8; ++i) { const bf16_t* row = P + (t0 + 8 * r + i) * NPROJ; la8[i] = *(const u32x4*)(row + C_LA + 64 * h + 8 * c); k8[i] = *(const u32x4*)(row + C_K + 64 * h + 8 * c); v8[i] = *(const u32x4*)(row + C_V + 128 * h + 64 * eh + 8 * c); }
#pragma unroll
        for (int i = 0; i < 8; ++i) { LAS u32x2* d = (LAS u32x2*)(vt + (8 * r + i) * TS136 + 16 * c); d[0] = (u32x2){v8[i].x, v8[i].y}; d[1] = (u32x2){v8[i].z, v8[i].w}; }
    }
    float bq[8][8], bl[8];
    chunk_cumsum(la8, bq, bl, lane);
#pragma unroll
    for (int i = 0; i < 8; ++i) { float kf[8]; unpack8(k8[i], kf);
#pragma unroll
        for (int j = 0; j < 8; ++j) kf[j] *= __expf(bl[j] - bq[i][j]);
        LAS u32x2* d = (LAS u32x2*)(kt + (8 * r + i) * TS136 + 16 * c); d[0] = (u32x2){pk2(kf[0], kf[1]), pk2(kf[2], kf[3])}; d[1] = (u32x2){pk2(kf[4], kf[5]), pk2(kf[6], kf[7])}; }
    if (eh == 0 && r == 7) { float* dp = DEC + (size_t)chi * 64 + 8 * c;
#pragma unroll
        for (int j = 0; j < 8; ++j) dp[j] = __expf(bl[j]); }
    asm volatile("s_waitcnt lgkmcnt(0)" ::: "memory");
    f32x4 acc[4][4];
#pragma unroll
    for (int m = 0; m < 4; ++m)
#pragma unroll
        for (int nn = 0; nn < 4; ++nn) acc[m][nn] = (f32x4){0.f, 0.f, 0.f, 0.f};
    const int q4 = fr >> 2, p4 = fr & 3;
    const unsigned abase = (unsigned)(size_t)vt + (unsigned)((8 * g + q4) * TS136 + 8 * p4), bbase = (unsigned)(size_t)kt + (unsigned)((8 * g + q4) * TS136 + 8 * p4);
#pragma unroll
    for (int ks = 0; ks < 2; ++ks) {
        u32x2 alo[4], ahi[4], blo[4], bhi[4];
#pragma unroll
        for (int m = 0; m < 4; ++m) { TR_ISSUE(alo[m], abase, ks * 32 * TS136 + m * 32); TR_ISSUE(ahi[m], abase, ks * 32 * TS136 + 4 * TS136 + m * 32); }
#pragma unroll
        for (int nn = 0; nn < 4; ++nn) { TR_ISSUE(blo[nn], bbase, ks * 32 * TS136 + nn * 32); TR_ISSUE(bhi[nn], bbase, ks * 32 * TS136 + 4 * TS136 + nn * 32); }
        TR_WAIT4(alo[0], alo[1], alo[2], alo[3]); TR_WAIT4(ahi[0], ahi[1], ahi[2], ahi[3]); TR_WAIT4(blo[0], blo[1], blo[2], blo[3]); TR_WAIT4(bhi[0], bhi[1], bhi[2], bhi[3]);
#pragma unroll
        for (int m = 0; m < 4; ++m)
#pragma unroll
            for (int nn = 0; nn < 4; ++nn) acc[m][nn] = mfma16(mk8(alo[m], ahi[m]), mk8(blo[nn], bhi[nn]), acc[m][nn]);
    }
    bf16_t* out = KVT + (size_t)chi * 8192;
#pragma unroll
    for (int m = 0; m < 4; ++m)
#pragma unroll
        for (int nn = 0; nn < 4; ++nn)
#pragma unroll
            for (int q = 0; q < 4; ++q) out[(64 * eh + 16 * m + 4 * g + q) * 64 + 16 * nn + fr] = (bf16_t)f2bf(acc[m][nn][q]);
}

template <bool FINAL>
__device__ __forceinline__ void lru_tile(Frame& F, LAS float* cw, LAS unsigned char* axl, LAS unsigned char* ot, int tile, int h) {
    const bf16_t* P = (const bf16_t*)(F.ws + WS_PROJ); float* LSUM = (float*)(F.ws + WS_LSUM); bf16_t* MIX = (bf16_t*)(F.ws + WS_H);
    const bf16_t* LW = (const bf16_t*)(F.ws + WS_LRUW); u32x4* STASH = (u32x4*)(F.ws + WS_X1) + ((size_t)(tile * LH + h) * 64) * 64;
    const int lane = F.lane, fr = lane & 15, g = lane >> 4;
    const int b = tile / 32, c256 = tile % 32;
    float lc_[4], carry[4], PM[4];
#pragma unroll
    for (int n = 0; n < 4; ++n) { const float nl = -F.in[14][64 * h + 16 * n + fr]; lc_[n] = -8.0f * 1.4426950408889634f * (fmaxf(nl, 0.f) + log1pf(__expf(-fabsf(nl)))); carry[n] = 0.f; PM[n] = 1.f; }
    const size_t tbase = (size_t)tile * 256;
    if constexpr (!FINAL) {
#pragma unroll
        for (int k = 0; k < 4; ++k) cw[k * 64 + lane] = F.in[8][k * DL + 64 * h + lane];
        cw[256 + lane] = F.in[9][64 * h + lane];
        float br_[4], bi_[4];
        bf16x8 Br[4][2], Bi[4][2];
#pragma unroll
        for (int n = 0; n < 4; ++n) {
            const int ch = 64 * h + 16 * n + fr;
#pragma unroll
            for (int ks = 0; ks < 2; ++ks) {
                Br[n][ks] = *(const bf16x8*)(LW + ((size_t)(0 * 8 + h) * 64 + 16 * n + fr) * 64 + 32 * ks + 8 * g);
                Bi[n][ks] = *(const bf16x8*)(LW + ((size_t)(1 * 8 + h) * 64 + 16 * n + fr) * 64 + 32 * ks + 8 * g);
            }
            br_[n] = F.in[11][ch]; bi_[n] = F.in[13][ch];
        }
        asm volatile("s_waitcnt lgkmcnt(0)" ::: "memory");
#pragma unroll 1
        for (int sc = 0; sc < 4; ++sc) {
#pragma unroll 2
            for (int m = 0; m < 4; ++m) {
                const size_t t = tbase + sc * 64 + m * 16 + fr; const int pos = (int)(t % SEQ);
#pragma unroll
                for (int ks = 0; ks < 2; ++ks) {
                    const int c0 = 32 * ks + 8 * g;
                    float xc[8];
                    { const LAS f32x4* bp = (const LAS f32x4*)(cw + 256 + c0); const f32x4 b0 = bp[0], b1 = bp[1]; xc[0] = b0.x; xc[1] = b0.y; xc[2] = b0.z; xc[3] = b0.w; xc[4] = b1.x; xc[5] = b1.y; xc[6] = b1.z; xc[7] = b1.w; }
#pragma unroll
                    for (int k = 0; k < 4; ++k) {
                        u32x4 w = {0u, 0u, 0u, 0u};
                        if (pos - 3 + k >= 0) w = __builtin_nontemporal_load((const u32x4*)(P + (t - 3 + k) * NPROJ + C_LX + 64 * h + c0));
                        float xf[8]; unpack8(w, xf);
                        const LAS f32x4* wp = (const LAS f32x4*)(cw + k * 64 + c0); const f32x4 w0 = wp[0], w1 = wp[1];
                        xc[0] += w0.x * xf[0]; xc[1] += w0.y * xf[1]; xc[2] += w0.z * xf[2]; xc[3] += w0.w * xf[3]; xc[4] += w1.x * xf[4]; xc[5] += w1.y * xf[5]; xc[6] += w1.z * xf[6]; xc[7] += w1.w * xf[7];
                    }
                    *(LAS u32x4*)(axl + ((m * 2 + ks) * 64 + lane) * 16) = (u32x4){pk2(xc[0], xc[1]), pk2(xc[2], xc[3]), pk2(xc[4], xc[5]), pk2(xc[6], xc[7])};
                }
            }
            asm volatile("s_waitcnt lgkmcnt(0)" ::: "memory");
#pragma unroll 1
            for (int m = 0; m < 4; ++m) {
                bf16x8 A[2];
#pragma unroll
                for (int ks = 0; ks < 2; ++ks) A[ks] = *(const LAS bf16x8*)(axl + ((m * 2 + ks) * 64 + lane) * 16);
#pragma unroll
                for (int n = 0; n < 4; ++n) {
                    bf16x8 Id[2];
#pragma unroll
                    for (int ks = 0; ks < 2; ++ks) { bf16x8 id;
#pragma unroll
                        for (int j = 0; j < 8; ++j) id[j] = (32 * ks + 8 * g + j == 16 * n + fr) ? (short)0x3f80 : (short)0;
                        Id[ks] = id; }
                    f32x4 ar = {0.f, 0.f, 0.f, 0.f}, ai = ar, ax = ar;
#pragma unroll
                    for (int ks = 0; ks < 2; ++ks) { ar = mfma16(A[ks], Br[n][ks], ar); ai = mfma16(A[ks], Bi[n][ks], ai); ax = mfma16(A[ks], Id[ks], ax); }
                    u32x4 st; float a_[4], u_[4];
#pragma unroll
                    for (int q = 0; q < 4; ++q) {
                        const float rr = sigmoidf_(ar[q] + br_[n]), ii = sigmoidf_(ai[q] + bi_[n]);
                        const float a0 = __builtin_amdgcn_exp2f(rr * lc_[n]);
                        const float u0 = __builtin_amdgcn_sqrtf(fmaf(-a0, a0, 1.0f)) * ii * ax[q];
                        const unsigned w = pk2(rr, u0); st[q] = w;
                        a_[q] = __builtin_amdgcn_exp2f(bflo(w) * lc_[n]); u_[q] = bfhi(w);
                    }
                    STASH[((sc * 4 + m) * 4 + n) * 64 + lane] = st;
                    float Pq = a_[0] * a_[1] * a_[2] * a_[3];
                    float Hq = ((u_[0] * a_[1] + u_[1]) * a_[2] + u_[2]) * a_[3] + u_[3];
#pragma unroll
                    for (int off = 16; off < 64; off <<= 1) { const float Pp = __shfl_up(Pq, off), Hp = __shfl_up(Hq, off); if (lane >= off) { Hq = Hq + Pq * Hp; Pq = Pq * Pp; } }
                    const float Pl = __shfl(Pq, 48 + fr), Hl = __shfl(Hq, 48 + fr);
                    carry[n] = Hl + Pl * carry[n]; PM[n] *= Pl;
                }
            }
        }
        if (g == 0) {
#pragma unroll
            for (int n = 0; n < 4; ++n) *(f32x2*)(LSUM + ((size_t)tile * DL + 64 * h + 16 * n + fr) * 2) = (f32x2){PM[n], carry[n]};
        }
    } else {
#pragma unroll
        for (int n = 0; n < 4; ++n) {
            f32x2 sv[8];
#pragma unroll
            for (int i = 0; i < 8; ++i) { const int cp = 8 * g + i; sv[i] = (f32x2){1.f, 0.f}; if (cp < c256) sv[i] = *(const f32x2*)(LSUM + ((size_t)(b * 32 + cp) * DL + 64 * h + 16 * n + fr) * 2); }
            float Pg = 1.f, Hg = 0.f;
#pragma unroll
            for (int i = 0; i < 8; ++i) { Hg = sv[i].y + sv[i].x * Hg; Pg *= sv[i].x; }
            float cy = 0.f;
#pragma unroll
            for (int gg = 0; gg < 4; ++gg) { const float Ps = __shfl(Pg, 16 * gg + fr), Hs = __shfl(Hg, 16 * gg + fr); cy = Hs + Ps * cy; }
            carry[n] = cy;
        }
#pragma unroll 1
        for (int sc = 0; sc < 4; ++sc) {
#pragma unroll 2
            for (int m = 0; m < 4; ++m) {
                u32x4 st[4];
#pragma unroll
                for (int n = 0; n < 4; ++n) st[n] = __builtin_nontemporal_load(STASH + ((sc * 4 + m) * 4 + n) * 64 + lane);
#pragma unroll
                for (int n = 0; n < 4; ++n) {
                    float a_[4], u_[4];
#pragma unroll
                    for (int q = 0; q < 4; ++q) { a_[q] = __builtin_amdgcn_exp2f(bflo(st[n][q]) * lc_[n]); u_[q] = bfhi(st[n][q]); }
                    float Pq = a_[0] * a_[1] * a_[2] * a_[3];
                    float Hq = ((u_[0] * a_[1] + u_[1]) * a_[2] + u_[2]) * a_[3] + u_[3];
#pragma unroll
                    for (int off = 16; off < 64; off <<= 1) { const float Pp = __shfl_up(Pq, off), Hp = __shfl_up(Hq, off); if (lane >= off) { Hq = Hq + Pq * Hp; Pq = Pq * Pp; } }
                    float Pe = __shfl_up(Pq, 16), He = __shfl_up(Hq, 16); if (lane < 16) { Pe = 1.f; He = 0.f; }
                    float hh = He + Pe * carry[n];
#pragma unroll
                    for (int q = 0; q < 4; ++q) { hh = a_[q] * hh + u_[q]; *(LAS unsigned short*)(ot + (16 * m + 4 * g + q) * TS136 + (16 * n + fr) * 2) = (unsigned short)f2bf(hh); }
                    const float Pl = __shfl(Pq, 48 + fr), Hl = __shfl(Hq, 48 + fr);
                    carry[n] = Hl + Pl * carry[n];
                }
            }
            asm volatile("s_waitcnt lgkmcnt(0)" ::: "memory");
#pragma unroll
            for (int i = 0; i < 8; ++i) { const int row = 8 * i + (lane >> 3), cc = lane & 7; const LAS u32x2* s = (const LAS u32x2*)(ot + row * TS136 + 16 * cc); const u32x2 lo = s[0], hi = s[1];
                const size_t t = tbase + sc * 64 + row;
                float hf[8], yf[8]; unpack8((u32x4){lo.x, lo.y, hi.x, hi.y}, hf); unpack8(__builtin_nontemporal_load((const u32x4*)(P + t * NPROJ + C_LY + 64 * h + 8 * cc)), yf);
#pragma unroll
                for (int j = 0; j < 8; ++j) hf[j] *= gelu_tanh(yf[j]);
                *(u32x4*)(MIX + t * D + 64 * h + 8 * cc) = (u32x4){pk2(hf[0], hf[1]), pk2(hf[2], hf[3]), pk2(hf[4], hf[5]), pk2(hf[6], hf[7])}; }
            asm volatile("s_waitcnt lgkmcnt(0)" ::: "memory");
        }
    }
}

__device__ __forceinline__ void phase_mix_a(Frame& F) {
    LAS unsigned char* wb = F.lds + F.wave * (2 * 64 * TS136);
    for (int tile = (F.grp * NTG) + F.vb; tile < (F.grp * NTG) + NTG; tile += F.vg) lru_tile<false>(F, (LAS float*)wb, wb + 1280, nullptr, tile, F.wave);
    asm volatile("s_waitcnt lgkmcnt(0)" ::: "memory");
    for (int it = 4 * (F.grp * NTG) + F.vb; it < 4 * ((F.grp * NTG) + NTG); it += F.vg) gla_kv_task(F, wb, wb + 64 * TS136, it / 128, it % 128, F.wave >> 1, F.wave & 1);
}

__device__ __forceinline__ void phase_mix_b(Frame& F) {
    const bf16_t* KVT = grp_kvt(F); const float* DEC = (const float*)(F.ws + WS_DEC); bf16_t* ST = grp_st(F);
    for (int gid = F.vb * 512 + F.tid; gid < (NB / NGRP) * GH * 4096; gid += F.vg * 512) {
        const int bh = gid >> 12, rem = gid & 4095, b = F.grp * (NB / NGRP) + (bh >> 2), h = bh & 3;
        f32x2 S = {0.f, 0.f};
        for (int n0 = 0; n0 < 128; n0 += 16) {
            unsigned kv[16]; f32x2 dc[16];
#pragma unroll
            for (int q = 0; q < 16; ++q) { const size_t chi = (size_t)(b * 128 + n0 + q) * 4 + h; kv[q] = __builtin_nontemporal_load((const unsigned*)(KVT + chi * 8192 + rem * 2)); dc[q] = *(const f32x2*)(DEC + chi * 64 + (rem & 31) * 2); }
#pragma unroll
            for (int q = 0; q < 16; ++q) { const size_t chi = (size_t)(b * 128 + n0 + q) * 4 + h; *(unsigned*)(ST + chi * 8192 + rem * 2) = pk2(S.x, S.y); S = dc[q] * S + (f32x2){bflo(kv[q]), bfhi(kv[q])}; }
        }
    }
}

__device__ __forceinline__ void phase_mix_c(Frame& F) {
    const bf16_t* P = (const bf16_t*)(F.ws + WS_PROJ); const bf16_t* ST = grp_st(F); bf16_t* MIX = (bf16_t*)(F.ws + WS_H);
    const int lane = F.lane, r = lane >> 3, c = lane & 7, fr = lane & 15, g = lane >> 4, h = F.wave >> 1, eh = F.wave & 1;
    constexpr int HEAD_LDS = 2 * 64 * TS144 + 2 * 64 * TS136;
    LAS unsigned char* qt = F.lds + h * HEAD_LDS; LAS unsigned char* kdt = qt + 64 * TS144; LAS unsigned char* vt = kdt + 64 * TS144 + eh * 64 * TS136;
    LAS float* ssx = (LAS float*)(F.lds + 4 * HEAD_LDS);
    for (int tile = (F.grp * NTG) + F.vb; tile < (F.grp * NTG) + NTG; tile += F.vg)
        lru_tile<true>(F, (LAS float*)(F.lds + F.wave * 18176 + 8704), F.lds + F.wave * 18176 + 8704 + 1280, F.lds + F.wave * 18176, tile, F.wave);
    __syncthreads();
    for (int it = 4 * (F.grp * NTG) + F.vb; it < 4 * ((F.grp * NTG) + NTG); it += F.vg) {
        {
            const int b = it / 128, n = it % 128; const size_t t0 = (size_t)b * SEQ + (size_t)n * 64; const int chi = (b * 128 + n) * 4 + h;
            bf16x8 As[4][2]; u32x2 gw[4][4];
            {
                u32x4 la8[8], x8[8];
                {
                    u32x4 v8[8];
#pragma unroll
                    for (int i = 0; i < 8; ++i) { const bf16_t* row = P + (t0 + 8 * r + i) * NPROJ; la8[i] = __builtin_nontemporal_load((const u32x4*)(row + C_LA + 64 * h + 8 * c)); x8[i] = __builtin_nontemporal_load((const u32x4*)(row + (eh ? C_Q : C_K) + 64 * h + 8 * c)); v8[i] = __builtin_nontemporal_load((const u32x4*)(row + C_V + 128 * h + 64 * eh + 8 * c)); }
#pragma unroll
                    for (int m = 0; m < 4; ++m)
#pragma unroll
                        for (int ks = 0; ks < 2; ++ks) As[m][ks] = __builtin_nontemporal_load((const bf16x8*)(ST + (size_t)chi * 8192 + (size_t)(64 * eh + 16 * m + fr) * 64 + 32 * ks + 8 * g));
#pragma unroll
                    for (int nn = 0; nn < 4; ++nn)
#pragma unroll
                        for (int m = 0; m < 4; ++m) gw[nn][m] = __builtin_nontemporal_load((const u32x2*)(P + (t0 + 16 * nn + fr) * NPROJ + C_G + 128 * h + 64 * eh + 16 * m + 4 * g));
#pragma unroll
                    for (int i = 0; i < 8; ++i) { LAS u32x2* d = (LAS u32x2*)(vt + (8 * r + i) * TS136 + 16 * c); d[0] = (u32x2){v8[i].x, v8[i].y}; d[1] = (u32x2){v8[i].z, v8[i].w}; }
                }
                float bq[8][8], bl[8];
                chunk_cumsum(la8, bq, bl, lane);
                LAS unsigned char* dst = eh ? qt : kdt;
#pragma unroll
                for (int i = 0; i < 8; ++i) { float xf[8]; unpack8(x8[i], xf);
#pragma unroll
                    for (int j = 0; j < 8; ++j) xf[j] *= eh ? 0.125f * __expf(bq[i][j]) : __expf(-bq[i][j]);
                    *(LAS u32x4*)(dst + (8 * r + i) * TS144 + 16 * c) = (u32x4){pk2(xf[0], xf[1]), pk2(xf[2], xf[3]), pk2(xf[4], xf[5]), pk2(xf[6], xf[7])}; }
            }
            __syncthreads();
            bf16x8 Bq[4][2], Bp[4][2];
#pragma unroll
            for (int nn = 0; nn < 4; ++nn)
#pragma unroll
                for (int ks = 0; ks < 2; ++ks) Bq[nn][ks] = *(const LAS bf16x8*)(qt + (16 * nn + fr) * TS144 + 64 * ks + 16 * g);
            {
                f32x4 Pm[4][4];
#pragma unroll
                for (int mp = 0; mp < 4; ++mp) {
                    bf16x8 Ak[2];
#pragma unroll
                    for (int ks = 0; ks < 2; ++ks) Ak[ks] = *(const LAS bf16x8*)(kdt + (16 * mp + fr) * TS144 + 64 * ks + 16 * g);
#pragma unroll
                    for (int nn = 0; nn < 4; ++nn) { f32x4 p = {0.f, 0.f, 0.f, 0.f};
#pragma unroll
                        for (int ks = 0; ks < 2; ++ks) p = mfma16(Ak[ks], Bq[nn][ks], p);
#pragma unroll
                        for (int q = 0; q < 4; ++q) if (16 * nn + fr < 16 * mp + 4 * g + q) p[q] = 0.f;
                        Pm[mp][nn] = p; }
                }
#pragma unroll
                for (int nn = 0; nn < 4; ++nn)
#pragma unroll
                    for (int i = 0; i < 2; ++i) { const f32x4 lo = Pm[2 * i][nn], hi = Pm[2 * i + 1][nn];
                        u32x4 w = {pk2(lo[0], lo[1]), pk2(lo[2], lo[3]), pk2(hi[0], hi[1]), pk2(hi[2], hi[3])}; Bp[nn][i] = __builtin_bit_cast(bf16x8, w); }
            }
            f32x4 acc[4][4];
#pragma unroll
            for (int m = 0; m < 4; ++m)
#pragma unroll
                for (int nn = 0; nn < 4; ++nn) acc[m][nn] = (f32x4){0.f, 0.f, 0.f, 0.f};
            const int q4 = fr >> 2, p4 = fr & 3;
            const unsigned abase = (unsigned)(size_t)vt + (unsigned)((4 * g + q4) * TS136 + 8 * p4);
#pragma unroll
            for (int i = 0; i < 2; ++i) {
                u32x2 alo[4], ahi[4];
#pragma unroll
                for (int m = 0; m < 4; ++m) { TR_ISSUE(alo[m], abase, i * 32 * TS136 + m * 32); TR_ISSUE(ahi[m], abase, i * 32 * TS136 + 16 * TS136 + m * 32); }
                TR_WAIT4(alo[0], alo[1], alo[2], alo[3]); TR_WAIT4(ahi[0], ahi[1], ahi[2], ahi[3]);
#pragma unroll
                for (int m = 0; m < 4; ++m)
#pragma unroll
                    for (int nn = 0; nn < 4; ++nn) acc[m][nn] = mfma16(mk8(alo[m], ahi[m]), Bp[nn][i], acc[m][nn]);
            }
#pragma unroll
            for (int m = 0; m < 4; ++m)
#pragma unroll
                for (int nn = 0; nn < 4; ++nn)
#pragma unroll
                    for (int ks = 0; ks < 2; ++ks) acc[m][nn] = mfma16(As[m][ks], Bq[nn][ks], acc[m][nn]);
            float ss[4];
#pragma unroll
            for (int nn = 0; nn < 4; ++nn) { float s = 0.f;
#pragma unroll
                for (int m = 0; m < 4; ++m) s += (acc[m][nn][0] * acc[m][nn][0] + acc[m][nn][1] * acc[m][nn][1]) + (acc[m][nn][2] * acc[m][nn][2] + acc[m][nn][3] * acc[m][nn][3]);
                s += __shfl_xor(s, 16); s += __shfl_xor(s, 32); ss[nn] = s;
                if (g == 0) ssx[F.wave * 64 + 16 * nn + fr] = s; }
            __syncthreads();
#pragma unroll
            for (int nn = 0; nn < 4; ++nn) {
                const float rstd = rsqrtf((ss[nn] + ssx[(F.wave ^ 1) * 64 + 16 * nn + fr]) * (1.0f / 128.0f) + EPS);
                const size_t t = t0 + 16 * nn + fr;
#pragma unroll
                for (int m = 0; m < 4; ++m) {
                    const int e0 = 128 * h + 64 * eh + 16 * m + 4 * g;
                    const u32x2 gv = gw[nn][m];
                    const f32x4 gn = *(const f32x4*)(F.in[17] + 64 * eh + 16 * m + 4 * g);
                    const float y0 = acc[m][nn][0] * rstd * gn.x * siluf_(bflo(gv.x)), y1 = acc[m][nn][1] * rstd * gn.y * siluf_(bfhi(gv.x));
                    const float y2 = acc[m][nn][2] * rstd * gn.z * siluf_(bflo(gv.y)), y3 = acc[m][nn][3] * rstd * gn.w * siluf_(bfhi(gv.y));
                    *(u32x2*)(MIX + t * D + DL + e0) = (u32x2){pk2(y0, y1), pk2(y2, y3)};
                }
            }
        }
    }
}


__global__ void __launch_bounds__(512, 2) fwd(Args args) {
    extern __shared__ __attribute__((aligned(16))) unsigned char lds_raw[];
    Frame F; F.lds = (LAS unsigned char*)lds_raw; F.tid = threadIdx.x; F.lane = F.tid & 63; F.wave = __builtin_amdgcn_readfirstlane(F.tid >> 6);
    F.in = args.in; F.ws = args.ws; F.out = args.out;
    const int bx = (int)blockIdx.x;
    F.grp = (NGRP == 2) ? ((bx >> 3) & 1) : 0; F.vg = (int)gridDim.x / NGRP; F.vb = (NGRP == 2) ? ((bx & 7) | ((bx >> 4) << 3)) : bx;
    volatile LAS unsigned* bst = (volatile LAS unsigned*)(F.lds + LDS_BYTES - 32);
    if (F.tid < 4) bst[F.tid] = 0u;
    __syncthreads();
#define BAR_FULL()  XcdBarrier{(unsigned*)(F.ws + WS_CTL) + 1024, xb_xcc_id(), (volatile LAS unsigned*)(F.lds + LDS_BYTES - 32), (unsigned)gridDim.x}
#define BAR_GROUP() XcdBarrier{(unsigned*)(F.ws + WS_CTL) + 1024 + 4096 * (1 + F.grp), xb_xcc_id(), (volatile LAS unsigned*)(F.lds + LDS_BYTES - 24), (unsigned)F.vg}
    (void)xcd_barrier_post((unsigned*)(F.ws + WS_CTL) + 1024, bst, gridDim.x);
    (void)xcd_barrier_post((unsigned*)(F.ws + WS_CTL) + 1024 + 4096 * (1 + F.grp), bst + 2, (unsigned)F.vg);

#define FRESH() do { int t_ = threadIdx.x; asm volatile("" : "+v"(t_)); F.tid = t_; F.lane = t_ & 63; } while (0)
    phase_p0a<0>(F);
    xcd_barrier(BAR_FULL());
    FRESH();
    if (F.grp == NGRP - 1) phase_p0a<1>(F);
    FRESH();
    phase_p0b(F);
    xcd_barrier(BAR_GROUP());
    if (F.grp == NGRP - 1 && F.tid == 0) __hip_atomic_fetch_add((unsigned*)(F.ws + WS_CTL) + 512, 1u, __ATOMIC_RELAXED, __HIP_MEMORY_SCOPE_AGENT);
    {
        DenseFast S{(const bf16_t*)(F.ws + WS_H), (const bf16_t*)(F.ws + WS_WIN), D, NTG, NPROJ / 256, F.vg, F.vb, (F.grp * NTG)};
        EpiProj E{(bf16_t*)(F.ws + WS_PROJ), F.in[16]};
        gemm_fast<EpiProj, DenseFast, false>(F.lds, S, E);
    }
    xcd_barrier(BAR_GROUP());
    FRESH();
    phase_mix_a(F);
    xcd_barrier(BAR_GROUP());
    FRESH();
    phase_mix_b(F);
    xcd_barrier(BAR_GROUP());
    FRESH();
    phase_mix_c(F);
    xcd_barrier(BAR_GROUP());
    {
        DenseFast S{(const bf16_t*)(F.ws + WS_H), (const bf16_t*)(F.ws + WS_WOUT), D, NTG, D / 256, F.vg, F.vb, (F.grp * NTG)};
        EpiX1 E{(bf16_t*)(F.ws + WS_X1), F.in[0], (const float*)(F.ws + WS_MOD), (float*)(F.ws + WS_SS)};
        gemm_fast<EpiX1, DenseFast, false>(F.lds, S, E);
    }
    xcd_barrier(BAR_GROUP());
    FRESH();
    phase_route(F);
    xcd_barrier(BAR_GROUP());
    FRESH();
    phase_slots(F);
    xcd_barrier(BAR_GROUP());
    {
        if (F.tid == 0) { unsigned* rdy = (unsigned*)(F.ws + WS_CTL) + 512; unsigned sp = 0;
            while (__hip_atomic_load(rdy, __ATOMIC_RELAXED, __HIP_MEMORY_SCOPE_AGENT) < (unsigned)F.vg) { __builtin_amdgcn_s_sleep(4); if (++sp > (1u << 22)) break; }
            __builtin_amdgcn_fence(__ATOMIC_ACQUIRE, "agent"); asm volatile("s_waitcnt vmcnt(0)" ::: "memory"); }
        __syncthreads();
    }
    {
        LAS unsigned* rowoff = (LAS unsigned*)(F.lds + 131072); LAS int* tileE = (LAS int*)(F.lds + 140800); LAS int* tileRow = tileE + 640; LAS int* tmp = tileRow + 640;
        const int nt = moe_tiles(F, tileE, tileRow, tmp);
        MoeFast S{(const bf16_t*)(F.ws + WS_H), (const bf16_t*)(F.ws + WS_WGU), D, (size_t)D * D, tileE, tileRow, rowoff, nt, F.vg, F.vb};
        const int* slot_tok = (const int*)(F.ws + WS_SLOTT);
        for (int i = 0; i < 9; ++i) { const int w = S.unit_id(i); if (w < 0) break; const int r0 = tileRow[w >> 2];
            if (F.tid < 256) rowoff[i * 256 + F.tid] = (unsigned)slot_tok[r0 + F.tid] * (unsigned)(D * 2); }
        __syncthreads();
        EpiSwiglu E{grp_hid(F)};
        gemm_fast<EpiSwiglu, MoeFast, true>(F.lds, S, E);
    }
    xcd_barrier(BAR_GROUP());
    {
        LAS int* tileE = (LAS int*)(F.lds + 140800); LAS int* tileRow = tileE + 640; LAS int* tmp = tileRow + 640;
        const int nt = moe_tiles(F, tileE, tileRow, tmp);
        MoeFast S{grp_hid(F), (const bf16_t*)(F.ws + WS_WD), DE, (size_t)D * DE, tileE, tileRow, nullptr, nt, F.vg, F.vb};
        EpiDown E{grp_o(F), (const float*)(F.ws + WS_SLOTW)};
        gemm_fast<EpiDown, MoeFast, false>(F.lds, S, E);
    }
    xcd_barrier(BAR_GROUP());
    FRESH();
    phase_final(F);
}

extern "C" void kernel_launch(void* const* d_in, const int* in_sizes, int n_in, void* d_out, int out_size, void* d_ws, size_t ws_size, hipStream_t stream) {
    static int grid = 0;
    if (grid == 0) {
        if (n_in != 26 || in_sizes[0] != T * D || out_size != T * D || ws_size < WS_END) { fprintf(stderr, "kernel_launch: unexpected shapes (n_in %d, in0 %d, out %d, ws %zu)\n", n_in, n_in > 0 ? in_sizes[0] : -1, out_size, ws_size); grid = -1; return; }
        int dev = 0, cus = 0;
        if (hipGetDevice(&dev) != hipSuccess || hipDeviceGetAttribute(&cus, hipDeviceAttributeMultiprocessorCount, dev) != hipSuccess) { grid = -1; return; }
        if (hipFuncSetAttribute((const void*)fwd, hipFuncAttributeMaxDynamicSharedMemorySize, LDS_BYTES) != hipSuccess) { fprintf(stderr, "kernel_launch: hipFuncSetAttribute failed\n"); grid = -1; return; }
        int per_cu = 0;
        if (hipOccupancyMaxActiveBlocksPerMultiprocessor(&per_cu, (const void*)fwd, 512, LDS_BYTES) != hipSuccess || per_cu < 1) { fprintf(stderr, "kernel_launch: occupancy query reports %d workgroups per CU\n", per_cu); }
        (void)hipGetLastError();
        grid = cus > 0 ? cus : 256;
        grid &= ~15;
        if (grid < 16) { grid = -1; return; }
    }
    if (grid < 0) return;
    (void)hipMemsetAsync((char*)d_ws + WS_CTL, 0, CTL_BYTES, stream);
    Args a{};
    for (int i = 0; i < 26; ++i) a.in[i] = (const float*)d_in[i];
    a.out = (float*)d_out; a.ws = (unsigned char*)d_ws;
    hipLaunchKernelGGL(fwd, dim3(grid), dim3(512), LDS_BYTES, stream, a);
}
```
